# Optimizing an MI355X kernel written in HIP

```python
import math
import jax
import jax.numpy as jnp
from jax import lax
import numpy as np

D_MODEL = 1024
BATCH = 4
SEQ = 8192
DEPTH = 2

GLA_HEADS = 4
GLA_DK = 64
GLA_DV = 128
GLA_RANK = 16
GLA_TAU = 16.0
DIFF_HEADS = 4
DIFF_DH = 64
ROT_DIM = DIFF_DH // 4
ROPE_THETA = 500000.0
Q_BLOCK = 128
GDN_HEADS = 4
GDN_DK = 128
GDN_DV = 128
CONV_W = 4
CHUNK = 64
N_BRANCH = 3
D_FF = 2816
N_EXPERTS = 8
TOP_K = 2
D_EXPERT = 3584
EPS = 1e-6
MAX_POS_OFFSET = 4096

GLA_QK = GLA_HEADS * GLA_DK
GLA_V = GLA_HEADS * GLA_DV
DIFF_QK = 2 * DIFF_HEADS * DIFF_DH
DIFF_V = DIFF_HEADS * 2 * DIFF_DH
GDN_QK = GDN_HEADS * GDN_DK
GDN_V = GDN_HEADS * GDN_DV
BRANCH_W = GLA_V
IN_SIZES = (GLA_QK, GLA_QK, GLA_V, GLA_V, GLA_RANK, GLA_RANK,
            DIFF_QK, DIFF_QK, DIFF_V,
            GDN_QK, GDN_QK, GDN_V, GDN_V, GDN_HEADS, GDN_HEADS, GDN_HEADS, GDN_HEADS,
            N_BRANCH * D_MODEL)
IN_SPLITS = tuple(int(s) for s in np.cumsum(IN_SIZES)[:-1])
IN_COLS = int(sum(IN_SIZES))
N_DENSE = (DEPTH + 1) // 2
N_MOE = DEPTH // 2

kernel_name = "hybrid_gla_diffattn_gdn_moe_encoder"


def rmsnorm(x, w):
    xf = x.astype(jnp.float32)
    y = xf * lax.rsqrt(jnp.mean(xf * xf, axis=-1, keepdims=True) + EPS)
    return (y * w.astype(jnp.float32)).astype(x.dtype)


def l2norm(x):
    return x * lax.rsqrt(jnp.sum(x * x, axis=-1, keepdims=True) + EPS)


def to_heads(t, n_heads):
    b, l, _ = t.shape
    return t.reshape(b, l, n_heads, -1).transpose(0, 2, 1, 3).astype(jnp.float32)


def from_heads(t):
    return t.transpose(0, 2, 1, 3)


def flip_seq(t):
    return jnp.flip(t, axis=2)


def partial_rope(x, pos):
    inv = ROPE_THETA ** (-jnp.arange(0, ROT_DIM, 2, dtype=jnp.float32) / ROT_DIM)
    ang = pos.astype(jnp.float32)[..., None] * inv
    cos = jnp.cos(ang)[:, :, None, :]
    sin = jnp.sin(ang)[:, :, None, :]
    xr = x[..., :ROT_DIM].astype(jnp.float32)
    x1, x2 = xr[..., :ROT_DIM // 2], xr[..., ROT_DIM // 2:]
    rot = jnp.concatenate([x1 * cos - x2 * sin, x2 * cos + x1 * sin], axis=-1).astype(x.dtype)
    return jnp.concatenate([rot, x[..., ROT_DIM:]], axis=-1)


def short_conv(x, w):
    return lax.conv_general_dilated(x, w[:, None, :].astype(x.dtype), window_strides=(1,), padding='SAME',
                                    dimension_numbers=('NWC', 'WIO', 'NWC'), feature_group_count=x.shape[-1])


def gla_chunked(q, k, v, g):
    B, H, L, dk = q.shape
    dv = v.shape[-1]
    n = L // CHUNK
    q = q.reshape(B, H, n, CHUNK, dk)
    k = k.reshape(B, H, n, CHUNK, dk)
    v = v.reshape(B, H, n, CHUNK, dv)
    b = jnp.cumsum(g.reshape(B, H, n, CHUNK, dk), axis=3)
    b_mid = b[:, :, :, CHUNK // 2 - 1:CHUNK // 2, :]
    b_last = b[:, :, :, -1:, :]
    incl = jnp.tril(jnp.ones((CHUNK, CHUNK), dtype=bool))
    a = jnp.einsum('bhnid,bhnjd->bhnij', q * jnp.exp(b - b_mid), k * jnp.exp(b_mid - b))
    a = jnp.where(incl, a, 0.0)
    o_intra = jnp.einsum('bhnij,bhnjv->bhniv', a, v)
    kv = jnp.einsum('bhncd,bhncv->bhndv', k * jnp.exp(b_last - b), v)
    decay = jnp.exp(b_last[:, :, :, 0, :])

    def step(s, xs):
        d_n, kv_n = xs
        return d_n[..., None] * s + kv_n, s

    s0 = jnp.zeros((B, H, dk, dv), jnp.float32)
    _, s_prev = lax.scan(step, s0, (jnp.moveaxis(decay, 2, 0), jnp.moveaxis(kv, 2, 0)))
    s_prev = jnp.moveaxis(s_prev, 0, 2)
    o_inter = jnp.einsum('bhncd,bhndv->bhncv', q * jnp.exp(b), s_prev)
    return (o_intra + o_inter).reshape(B, H, L, dv)


def gdn_chunked(q, k, v, g, beta):
    B, H, L, dk = q.shape
    dv = v.shape[-1]
    n = L // CHUNK
    q = q.reshape(B, H, n, CHUNK, dk)
    k = k.reshape(B, H, n, CHUNK, dk)
    v = v.reshape(B, H, n, CHUNK, dv)
    beta = beta.reshape(B, H, n, CHUNK)
    b = jnp.cumsum(g.reshape(B, H, n, CHUNK), axis=-1)
    incl = jnp.tril(jnp.ones((CHUNK, CHUNK), dtype=bool))
    strict = jnp.tril(jnp.ones((CHUNK, CHUNK), dtype=bool), k=-1)
    gamma = jnp.exp(jnp.where(incl, b[..., :, None] - b[..., None, :], -jnp.inf))
    kk = jnp.einsum('bhnid,bhnjd->bhnij', k, k)
    m = jnp.eye(CHUNK, dtype=jnp.float32) + jnp.where(strict, beta[..., :, None] * kk * gamma, 0.0)
    rhs = jnp.concatenate([v * beta[..., None], k * (beta * jnp.exp(b))[..., None]], axis=-1)
    sol = lax.linalg.triangular_solve(m, rhs, left_side=True, lower=True, unit_diagonal=True)
    u, w = sol[..., :dv], sol[..., dv:]
    attn = jnp.einsum('bhnid,bhnjd->bhnij', q, k) * gamma
    q_dec = q * jnp.exp(b)[..., None]
    k_end = k * jnp.exp(b[..., -1:] - b)[..., None]
    dec_last = jnp.exp(b[..., -1])

    def step(s, xs):
        u_n, w_n, q_n, k_n, a_n, d_n = xs
        v_new = u_n - jnp.einsum('bhcd,bhdv->bhcv', w_n, s)
        o_n = jnp.einsum('bhcd,bhdv->bhcv', q_n, s) + jnp.einsum('bhij,bhjv->bhiv', a_n, v_new)
        s = d_n[..., None, None] * s + jnp.einsum('bhcd,bhcv->bhdv', k_n, v_new)
        return s, o_n

    xs = tuple(jnp.moveaxis(t, 2, 0) for t in (u, w, q_dec, k_end, attn, dec_last))
    s0 = jnp.zeros((B, H, dk, dv), jnp.float32)
    _, o = lax.scan(step, s0, xs)
    return jnp.moveaxis(o, 0, 2).reshape(B, H, L, dv)


def diff_attention(q, k, v, lam):
    B, L, H2, d = q.shape
    H = H2 // 2
    scale = d ** -0.5
    qb = q.reshape(B, L // Q_BLOCK, Q_BLOCK, H2, d).transpose(1, 0, 3, 2, 4)
    kt = k.transpose(0, 2, 1, 3)
    vt = v.transpose(0, 2, 1, 3)

    def block(q_blk):
        s = jnp.einsum('bhqd,bhkd->bhqk', q_blk, kt).astype(jnp.float32) * scale
        p = jax.nn.softmax(s, axis=-1).reshape(B, H, 2, Q_BLOCK, L)
        a = p[:, :, 0] - lam * p[:, :, 1]
        return jnp.einsum('bhqk,bhkv->bhqv', a.astype(v.dtype), vt)

    o = lax.map(block, qb)
    return o.transpose(1, 0, 3, 2, 4).reshape(B, L, H, 2 * d)


def hybrid_mixer(h, pos, layer, w_in, gla_gate_up, gla_gate_bias, gla_norm, diff_lambda, diff_norm,
                 gdn_conv, gdn_A_log, gdn_dt_bias, gdn_norm, w_branch, w_out):
    f32 = jnp.float32
    B, L, _ = h.shape
    proj = h @ w_in
    (gq, gk, gv, gr, gwf, gwb, dq, dk, dv, nq, nk, nv, nz, nbf, nbb, naf, nab, mg) = jnp.split(proj, IN_SPLITS, axis=-1)

    q = to_heads(gq, GLA_HEADS) * (GLA_DK ** -0.5)
    k = to_heads(gk, GLA_HEADS)
    v = to_heads(gv, GLA_HEADS)

    def gla_log_gate(w_down, d):
        z = w_down.astype(f32) @ gla_gate_up[d].astype(f32) + gla_gate_bias[d].astype(f32)
        return to_heads(jax.nn.log_sigmoid(z) / GLA_TAU, GLA_HEADS)

    o = gla_chunked(q, k, v, gla_log_gate(gwf, 0)) + flip_seq(
        gla_chunked(flip_seq(q), flip_seq(k), flip_seq(v), flip_seq(gla_log_gate(gwb, 1))))
    o = rmsnorm(from_heads(o), gla_norm).reshape(B, L, GLA_V)
    y_gla = (o * jax.nn.silu(gr.astype(f32))).astype(h.dtype)

    qd = partial_rope(dq.reshape(B, L, 2 * DIFF_HEADS, DIFF_DH), pos)
    kd = partial_rope(dk.reshape(B, L, 2 * DIFF_HEADS, DIFF_DH), pos)
    vd = dv.reshape(B, L, DIFF_HEADS, 2 * DIFF_DH)
    lam_init = 0.8 - 0.6 * math.exp(-0.3 * layer)
    lp = diff_lambda.astype(f32)
    lam = jnp.exp(jnp.sum(lp[0] * lp[1])) - jnp.exp(jnp.sum(lp[2] * lp[3])) + lam_init
    od = diff_attention(qd, kd, vd, lam)
    y_diff = (rmsnorm(od, diff_norm).astype(f32) * (1.0 - lam_init)).reshape(B, L, DIFF_V).astype(h.dtype)

    qkv = jax.nn.silu(short_conv(jnp.concatenate([nq, nk, nv], axis=-1), gdn_conv))
    cq, ck, cv = jnp.split(qkv, [GDN_QK, 2 * GDN_QK], axis=-1)
    q = l2norm(to_heads(cq, GDN_HEADS)) * (GDN_DK ** -0.5)
    k = l2norm(to_heads(ck, GDN_HEADS))
    v = to_heads(cv, GDN_HEADS)

    def gdn_gates(b_logit, a_logit, d):
        beta = jax.nn.sigmoid(b_logit.astype(f32))
        g = -jnp.exp(gdn_A_log[d].astype(f32)) * jax.nn.softplus(a_logit.astype(f32) + gdn_dt_bias[d].astype(f32))
        return g.transpose(0, 2, 1), beta.transpose(0, 2, 1)

    g_f, beta_f = gdn_gates(nbf, naf, 0)
    g_b, beta_b = gdn_gates(nbb, nab, 1)
    o = gdn_chunked(q, k, v, g_f, beta_f) + flip_seq(
        gdn_chunked(flip_seq(q), flip_seq(k), flip_seq(v), flip_seq(g_b), flip_seq(beta_b)))
    z = nz.reshape(B, L, GDN_HEADS, GDN_DV).astype(f32)
    y_gdn = (rmsnorm(from_heads(o), gdn_norm) * jax.nn.silu(z)).reshape(B, L, GDN_V).astype(h.dtype)

    ys = jnp.stack([y_gla, y_diff, y_gdn], axis=2)
    branch = jnp.einsum('blnc,ncd->blnd', ys, w_branch)
    gates = jax.nn.sigmoid(mg.reshape(B, L, N_BRANCH, D_MODEL).astype(f32)).astype(h.dtype)
    merged = jnp.sum(gates * branch, axis=2)
    return merged @ w_out


def swiglu(h, w1, w3, w2):
    return (jax.nn.silu(h @ w1) * (h @ w3)) @ w2


def moe_swiglu(h, router_w, w1, w3, w2):
    B, L, D = h.shape
    t = h.reshape(B * L, D)
    logits = (t @ router_w).astype(jnp.float32)
    top_val, top_idx = lax.top_k(logits, TOP_K)
    top_w = jax.nn.softmax(top_val, axis=-1)
    combine = jnp.einsum('tk,tke->te', top_w, jax.nn.one_hot(top_idx, N_EXPERTS, dtype=jnp.float32)).astype(t.dtype)
    out = jnp.zeros_like(t)
    for e in range(N_EXPERTS):
        out = out + combine[:, e:e + 1] * swiglu(t, w1[e], w3[e], w2[e])
    return out.reshape(B, L, D)


def setup_inputs(seed: int = 0) -> dict:
    key = jax.random.key(seed)
    ks = jax.random.split(key, 32)
    f32 = jnp.float32

    def nrm(k, shape, scale):
        return jax.random.normal(k, shape, f32) * scale

    x = nrm(ks[0], (BATCH, SEQ, D_MODEL), 1.0)
    c = nrm(ks[1], (BATCH, D_MODEL), 1.0)
    positions = (jnp.arange(SEQ, dtype=jnp.int32)[None, :]
                 + jax.random.randint(ks[2], (BATCH, 1), 0, MAX_POS_OFFSET, dtype=jnp.int32))
    adaln_w = nrm(ks[3], (DEPTH, D_MODEL, 6 * D_MODEL), 0.5 * D_MODEL ** -0.5)
    adaln_b = nrm(ks[4], (DEPTH, 6 * D_MODEL), 0.02)
    norm_w = 1.0 + nrm(ks[5], (DEPTH, 4, D_MODEL), 0.05)
    w_in = nrm(ks[6], (DEPTH, D_MODEL, IN_COLS), D_MODEL ** -0.5)
    gla_gate_up = nrm(ks[7], (DEPTH, 2, GLA_RANK, GLA_QK), GLA_RANK ** -0.5)
    gla_gate_bias = nrm(ks[8], (DEPTH, 2, GLA_QK), 0.1)
    gla_norm = 1.0 + nrm(ks[9], (DEPTH, GLA_DV), 0.05)
    diff_lambda = nrm(ks[10], (DEPTH, 4, DIFF_DH), 0.1)
    diff_norm = 1.0 + nrm(ks[11], (DEPTH, 2 * DIFF_DH), 0.05)
    gdn_conv = nrm(ks[12], (DEPTH, CONV_W, 2 * GDN_QK + GDN_V), CONV_W ** -0.5)
    gdn_A_log = jnp.log(jax.random.uniform(ks[13], (DEPTH, 2, GDN_HEADS), f32, 1.0, 16.0))
    dt = jnp.exp(jax.random.uniform(ks[14], (DEPTH, 2, GDN_HEADS), f32, math.log(1e-3), math.log(1e-1)))
    gdn_dt_bias = dt + jnp.log(-jnp.expm1(-dt))
    gdn_norm = 1.0 + nrm(ks[15], (DEPTH, GDN_DV), 0.05)
    w_branch = nrm(ks[16], (DEPTH, N_BRANCH, BRANCH_W, D_MODEL), BRANCH_W ** -0.5)
    w_out = nrm(ks[17], (DEPTH, D_MODEL, D_MODEL), D_MODEL ** -0.5)
    ffn_w1 = nrm(ks[18], (N_DENSE, D_MODEL, D_FF), D_MODEL ** -0.5)
    ffn_w3 = nrm(ks[19], (N_DENSE, D_MODEL, D_FF), D_MODEL ** -0.5)
    ffn_w2 = nrm(ks[20], (N_DENSE, D_FF, D_MODEL), D_FF ** -0.5)
    router_w = nrm(ks[21], (N_MOE, D_MODEL, N_EXPERTS), D_MODEL ** -0.5)
    moe_w1 = nrm(ks[22], (N_MOE, N_EXPERTS, D_MODEL, D_EXPERT), D_MODEL ** -0.5)
    moe_w3 = nrm(ks[23], (N_MOE, N_EXPERTS, D_MODEL, D_EXPERT), D_MODEL ** -0.5)
    moe_w2 = nrm(ks[24], (N_MOE, N_EXPERTS, D_EXPERT, D_MODEL), D_EXPERT ** -0.5)
    return {"x": x, "c": c, "positions": positions, "adaln_w": adaln_w, "adaln_b": adaln_b,
            "norm_w": norm_w, "w_in": w_in, "gla_gate_up": gla_gate_up, "gla_gate_bias": gla_gate_bias,
            "gla_norm": gla_norm, "diff_lambda": diff_lambda, "diff_norm": diff_norm, "gdn_conv": gdn_conv,
            "gdn_A_log": gdn_A_log, "gdn_dt_bias": gdn_dt_bias, "gdn_norm": gdn_norm, "w_branch": w_branch,
            "w_out": w_out, "ffn_w1": ffn_w1, "ffn_w3": ffn_w3, "ffn_w2": ffn_w2, "router_w": router_w,
            "moe_w1": moe_w1, "moe_w3": moe_w3, "moe_w2": moe_w2}


def reference(x, c, positions, adaln_w, adaln_b, norm_w, w_in, gla_gate_up, gla_gate_bias, gla_norm,
              diff_lambda, diff_norm, gdn_conv, gdn_A_log, gdn_dt_bias, gdn_norm, w_branch, w_out,
              ffn_w1, ffn_w3, ffn_w2, router_w, moe_w1, moe_w3, moe_w2):
    mod = jnp.einsum('bd,lde->lbe', jax.nn.silu(c), adaln_w) + adaln_b[:, None, :]
    for layer in range(DEPTH):
        sh1, sc1, g1, sh2, sc2, g2 = jnp.split(mod[layer][:, None, :].astype(x.dtype), 6, axis=-1)
        h = rmsnorm(x, norm_w[layer, 0]) * (1.0 + sc1) + sh1
        y = hybrid_mixer(h, positions, layer, w_in[layer], gla_gate_up[layer], gla_gate_bias[layer],
                         gla_norm[layer], diff_lambda[layer], diff_norm[layer], gdn_conv[layer],
                         gdn_A_log[layer], gdn_dt_bias[layer], gdn_norm[layer], w_branch[layer], w_out[layer])
        x = x + g1 * rmsnorm(y, norm_w[layer, 1])
        h = rmsnorm(x, norm_w[layer, 2]) * (1.0 + sc2) + sh2
        if layer % 2 == 0:
            y = swiglu(h, ffn_w1[layer // 2], ffn_w3[layer // 2], ffn_w2[layer // 2])
        else:
            y = moe_swiglu(h, router_w[layer // 2], moe_w1[layer // 2], moe_w3[layer // 2], moe_w2[layer // 2])
        x = x + g2 * rmsnorm(y, norm_w[layer, 3])
    return x
```

```cpp
#include <hip/hip_runtime.h>
#include <cstdio>
#include <cstdint>

#ifndef MK_ONE_LAUNCH
#define MK_ONE_LAUNCH 0
#endif

constexpr int DM = 1024, NBATCH = 4, SEQ = 8192, TOK = NBATCH * SEQ, HBR = 16384;
constexpr int INC = 8240, LDP = 8448;
constexpr int C_GQ = 0, C_GK = 256, C_GV = 512, C_GR = 1024, C_GWF = 1536, C_GWB = 1552, C_DQ = 1568, C_DK = 2080, C_DV = 2592,
              C_NQ = 3104, C_NK = 3616, C_NV = 4128, C_NZ = 4640, C_NBF = 5152, C_NBB = 5156, C_NAF = 5160, C_NAB = 5164, C_MG = 5168;
constexpr int DFF = 2816, NEXP = 8, DEXP = 3584;
constexpr float EPS = 1e-6f;
constexpr int NTHREADS = 512, NWAVES = 8;
constexpr int MOE_MAXT = 264, MOE_PASS_T = 64, MOE_NPASS = 5;

constexpr size_t MiB = 1u << 20;
constexpr size_t WS_CTL = 0, CTL_ZERO_BYTES = 1 * MiB;
constexpr size_t WS_MODP = 1 * MiB;
constexpr size_t WS_ROUTE = 3 * MiB;
constexpr size_t WS_LPOS = 3 * MiB + 512 * 1024;
constexpr size_t WS_SLOTROW = 3 * MiB + 768 * 1024;
constexpr size_t WS_GCNT = 4 * MiB;
constexpr size_t WS_TILEEXP = 4 * MiB + 64 * 1024;
constexpr size_t WS_GATE = 5 * MiB;
constexpr size_t WS_WIN = 8 * MiB;
constexpr size_t WS_WB = WS_WIN + (size_t)LDP * DM * 2;
constexpr size_t WS_WO = WS_WB + 3u * 1024 * 512 * 2;
constexpr size_t WS_H = 32 * MiB;
constexpr size_t WS_PROJ = 96 * MiB;
constexpr size_t WS_QKVC = 360 * MiB;
constexpr size_t WS_OGLA = 408 * MiB;
constexpr size_t WS_OGDN = 472 * MiB;
constexpr size_t WS_YS = 536 * MiB;
constexpr size_t WS_W13 = 584 * MiB;
constexpr size_t WS_W2 = WS_W13 + (size_t)2 * DFF * DM * 2;
constexpr size_t WS_MERGEDF = 360 * MiB;
constexpr size_t WS_MERGED = 424 * MiB;
constexpr size_t WS_Y = 472 * MiB;
constexpr size_t WS_HID = 96 * MiB;
constexpr size_t WS_Y2 = 272 * MiB;
constexpr size_t WS_MW13 = 96 * MiB;
constexpr size_t WS_MW2 = 208 * MiB;
constexpr size_t WS_ASORT = 264 * MiB;
constexpr size_t WS_MHID = 396 * MiB;
constexpr size_t WS_END = 601 * MiB;
static_assert(WS_W2 + (size_t)DM * DFF * 2 <= WS_END && WS_WO + 2u * MiB <= WS_H && WS_HID + (size_t)TOK * DFF * 2 <= WS_Y2 && WS_MHID + 112 * MiB <= WS_END, "ws map");
constexpr int CW_BAR = 4096;

constexpr int RING_BYTES = 131072;
constexpr int LDS_BYTES = 147456;
constexpr int MISC_OFF = LDS_BYTES - 256;

#define LAS __attribute__((address_space(3)))
typedef unsigned short bf16;
typedef float f32x4 __attribute__((ext_vector_type(4)));
typedef unsigned u32x4 __attribute__((ext_vector_type(4)));
typedef unsigned u32x2 __attribute__((ext_vector_type(2)));

__device__ __forceinline__ unsigned cvtpk(float lo, float hi) { unsigned r; asm volatile("v_cvt_pk_bf16_f32 %0, %1, %2" : "=v"(r) : "v"(lo), "v"(hi)); return r; }
__device__ __forceinline__ float bflo(unsigned w) { return __uint_as_float(w << 16); }
__device__ __forceinline__ float bfhi(unsigned w) { return __uint_as_float(w & 0xffff0000u); }
__device__ __forceinline__ float bf2f(bf16 b) { return __uint_as_float(((unsigned)b) << 16); }
__device__ __forceinline__ bf16 f2bf(float f) { return (bf16)(cvtpk(f, 0.f) & 0xffffu); }
__device__ __forceinline__ void unpack8(const u32x4 w, float* x) { x[0] = bflo(w.x); x[1] = bfhi(w.x); x[2] = bflo(w.y); x[3] = bfhi(w.y); x[4] = bflo(w.z); x[5] = bfhi(w.z); x[6] = bflo(w.w); x[7] = bfhi(w.w); }
__device__ __forceinline__ u32x4 pack8(const float* x) { u32x4 w; w.x = cvtpk(x[0], x[1]); w.y = cvtpk(x[2], x[3]); w.z = cvtpk(x[4], x[5]); w.w = cvtpk(x[6], x[7]); return w; }
__device__ __forceinline__ float sigmoidf_(float x) { return 1.0f / (1.0f + __expf(-x)); }
__device__ __forceinline__ float siluf_(float x) { return x / (1.0f + __expf(-x)); }
__device__ __forceinline__ float wave_sum(float v) {
#pragma unroll
    for (int o = 1; o < 64; o <<= 1) v += __shfl_xor(v, o);
    return v;
}
__device__ __forceinline__ float grp16_sum(float v) {
#pragma unroll
    for (int o = 1; o < 16; o <<= 1) v += __shfl_xor(v, o);
    return v;
}

namespace pg8 {
#define PG8_LAS __attribute__((address_space(3)))
typedef unsigned short bf16_t;
typedef short bf16x8 __attribute__((ext_vector_type(8)));
typedef float f32x4 __attribute__((ext_vector_type(4)));
typedef unsigned u32x4 __attribute__((ext_vector_type(4)));
constexpr int BM = 256, BK = 64, HALF = 128, HTB = HALF * BK * 2  , STAGE_BYTES = 8 * HTB, NXCD = 8, WGM = 8;

__host__ __device__ __forceinline__ int lds_byte(int r, int c) { const int st = (r >> 4) * 2 + (c >> 5), rr = r & 15, cc = c & 31, ob = rr * 64 + cc * 2; return st * 1024 + (ob ^ (((ob >> 9) & 1) << 5)); }
__host__ __device__ __forceinline__ void stage_rc(int b, int& R, int& C) { const int st = b / 1024, sb = b % 1024, swz = sb ^ (((sb >> 9) & 1) << 5); R = (st >> 1) * 16 + swz / 64; C = (st & 1) * 32 + (swz % 64) / 2; }
__host__ __device__ __forceinline__ int perm32(int rho) { const int n = rho >> 4, i = rho & 15; return 8 * (i >> 2) + 4 * n + (i & 3); }

struct Unit { int pm, pn, aux; };
struct Gemm { const bf16_t* A; const bf16_t* Bt; int M, N, K; };

struct StaticOrder {
    int nM, nN, nwg, G, c;
    __host__ __device__ void init(int M, int N, int G_, int c_) { nM = M / BM; nN = N / BM; nwg = nM * nN; G = G_; c = c_; }
    __host__ __device__ bool next(int i, Unit& u) const {
        const long L = (long)i * G + c; if (L >= nwg) return false;
        int wgid = (int)L; { const int q = nwg / NXCD, r = nwg % NXCD, xcd = wgid % NXCD, off = wgid / NXCD; wgid = (xcd < r ? xcd * (q + 1) : r * (q + 1) + (xcd - r) * q) + off; }
        const int nig = WGM * nN, gid = wgid / nig, fm = gid * WGM, gsz = (nM - fm) < WGM ? (nM - fm) : WGM;
        u.pm = fm + ((wgid % nig) % gsz); u.pn = (wgid % nig) / gsz; return true;
    }
    __device__ __forceinline__ void a_ready(const Unit&) const {}
    __device__ __forceinline__ void done(const Unit&) const {}
};
struct CountedOrder : StaticOrder {
    const unsigned* ready; unsigned need; unsigned* tmo;
    __device__ __forceinline__ void a_ready(const Unit& u) const {
        if (threadIdx.x < 64) {
            const unsigned long long t0 = __builtin_amdgcn_s_memrealtime(); unsigned polls = 0;
            while ((unsigned)__builtin_amdgcn_readfirstlane(__hip_atomic_load(ready + 64 * u.pm, __ATOMIC_RELAXED, __HIP_MEMORY_SCOPE_AGENT)) < need) {
                if ((++polls & 255u) == 0u && __builtin_amdgcn_readfirstlane(__hip_atomic_load(tmo, __ATOMIC_RELAXED, __HIP_MEMORY_SCOPE_AGENT)) != 0u) break;
                if (__builtin_amdgcn_s_memrealtime() - t0 > 2000000ull) {
                    if (threadIdx.x == 0) { unsigned expect = 0u; __hip_atomic_compare_exchange_strong(tmo + 1, &expect, 0x600u | (unsigned)(u.pm & 0xff), __ATOMIC_RELAXED, __ATOMIC_RELAXED, __HIP_MEMORY_SCOPE_AGENT); __hip_atomic_store(tmo, 1u, __ATOMIC_RELAXED, __HIP_MEMORY_SCOPE_AGENT); }
                    break; }
                __builtin_amdgcn_s_sleep(2); }
            __builtin_amdgcn_fence(__ATOMIC_ACQUIRE, "agent");
            asm volatile("s_waitcnt vmcnt(0)" ::: "memory");
        }
#if !defined(BROKEN_HOOK_NO_BARRIER)
        asm volatile("" ::: "memory"); __builtin_amdgcn_s_barrier(); asm volatile("" ::: "memory");
#endif
    }
};

__device__ __forceinline__ unsigned cvt_pk_bf16(float lo, float hi) { unsigned r; asm volatile("v_cvt_pk_bf16_f32 %0, %1, %2" : "=v"(r) : "v"(lo), "v"(hi)); return r; }
typedef float f32x2 __attribute__((ext_vector_type(2)));
__device__ __forceinline__ f32x2 gelu_pk(f32x2 v) {
    const f32x2 av = __builtin_elementwise_abs(v), d = av * 0.2316418882f + 1.0f;
    f32x2 t; t.x = __builtin_amdgcn_rcpf(d.x); t.y = __builtin_amdgcn_rcpf(d.y);
    f32x2 q = t * 0.5307027145f + (-0.7265760135f); q = q * t + 0.7107068705f; q = q * t + (-0.142248368f); q = q * t + 0.127414796f; q = q * t;
    const f32x2 s = (v * v) * (-0.72134752044f);
    f32x2 e; e.x = __builtin_amdgcn_exp2f(s.x); e.y = __builtin_amdgcn_exp2f(s.y);
    const f32x2 m = v * (q * e), r = v - m;
    f32x2 o; o.x = v.x < 0.f ? m.x : r.x; o.y = v.y < 0.f ? m.y : r.y; return o;
}

struct EpiF32 {
    static constexpr bool PERM = false, AFTER_DRAIN = false;
    float* C; int ldc; const float* bias;
    __device__ __forceinline__ void operator()(const f32x4 (&acc)[2][2][4][2], const Unit& u, int wr, int wc, int fr, int fq) const {
        const int row0 = u.pm * BM + wr * 64 + fr, col0 = u.pn * BM + wc * 32 + 4 * fq;
        f32x4 bv[2][2];
#pragma unroll
        for (int bj = 0; bj < 2; ++bj)
#pragma unroll
            for (int n = 0; n < 2; ++n) bv[bj][n] = bias ? *(const f32x4*)(bias + col0 + bj * HALF + n * 16) : (f32x4){0.f, 0.f, 0.f, 0.f};
#pragma unroll
        for (int ai = 0; ai < 2; ++ai)
#pragma unroll
            for (int m = 0; m < 4; ++m) { float* rowp = C + (size_t)(row0 + ai * HALF + m * 16) * ldc + col0;
#pragma unroll
                for (int bj = 0; bj < 2; ++bj)
#pragma unroll
                    for (int n = 0; n < 2; ++n) *(f32x4*)(rowp + bj * HALF + n * 16) = acc[ai][bj][m][n] + bv[bj][n]; }
    }
};
template <int ACT  > struct EpiBf16 {
    static constexpr bool PERM = true, AFTER_DRAIN = false;
    bf16_t* O; int ldc; const float* bias; int split_cols; size_t split_stride;
    __device__ __forceinline__ void operator()(const f32x4 (&acc)[2][2][4][2], const Unit& u, int wr, int wc, int fr, int fq) const {
        const int row0 = u.pm * BM + wr * 64 + fr; int colt = u.pn * BM; bf16_t* base = O;
        if (split_cols) { const int t = colt / split_cols; base += (size_t)t * split_stride; colt -= t * split_cols; }
        const int col0 = colt + wc * 32 + 8 * fq, bcol0 = u.pn * BM + wc * 32 + 8 * fq;
        f32x4 bv[2][2];
#pragma unroll
        for (int bj = 0; bj < 2; ++bj)
#pragma unroll
            for (int n = 0; n < 2; ++n) bv[bj][n] = bias ? *(const f32x4*)(bias + bcol0 + bj * HALF + 4 * n) : (f32x4){0.f, 0.f, 0.f, 0.f};
#pragma unroll
        for (int ai = 0; ai < 2; ++ai)
#pragma unroll
            for (int m = 0; m < 4; ++m) { bf16_t* rowp = base + (size_t)(row0 + ai * HALF + m * 16) * ldc + col0;
#pragma unroll
                for (int bj = 0; bj < 2; ++bj) { f32x4 v0 = acc[ai][bj][m][0] + bv[bj][0], v1 = acc[ai][bj][m][1] + bv[bj][1];
                    if (ACT == 1) { f32x2 a = gelu_pk((f32x2){v0[0], v0[1]}), b = gelu_pk((f32x2){v0[2], v0[3]}), c = gelu_pk((f32x2){v1[0], v1[1]}), d = gelu_pk((f32x2){v1[2], v1[3]});
                        v0 = (f32x4){a.x, a.y, b.x, b.y}; v1 = (f32x4){c.x, c.y, d.x, d.y}; }
                    if (ACT == 2) {
#pragma unroll
                        for (int j = 0; j < 4; ++j) { v0[j] = 0.5f * v0[j] * (1.0f + erff(v0[j] * 0.70710678f)); v1[j] = 0.5f * v1[j] * (1.0f + erff(v1[j] * 0.70710678f)); } }
                    u32x4 w; w.x = cvt_pk_bf16(v0[0], v0[1]); w.y = cvt_pk_bf16(v0[2], v0[3]); w.z = cvt_pk_bf16(v1[0], v1[1]); w.w = cvt_pk_bf16(v1[2], v1[3]);
                    *(u32x4*)(rowp + bj * HALF) = w; } }
    }
};
template <class Epi, class Sched, bool STAMP = false>
__device__ __forceinline__ void gemm_phase(PG8_LAS unsigned char* lds, const Gemm g, const Sched& S, const Epi& E, unsigned long long* stamps) {
    int tid_ = threadIdx.x; asm volatile("" : "+v"(tid_));
    const int tid = tid_, wid = __builtin_amdgcn_readfirstlane(tid >> 6), lane = tid & 63, wr = wid >> 2, wc = wid & 3, fr = lane & 15, fq = lane >> 4;
    const int K = g.K, nt = K / BK;
    int ts_lo = 0, ts_hi = 0, nts = 0; const unsigned long long rt_entry = STAMP ? (unsigned long long)wall_clock64() : 0ull;
#define PG8_STAMP() do { if (STAMP && wid == 0 && nts < 64) { const unsigned long long _c = (unsigned long long)clock64(); \
        ts_lo = (lane == nts) ? (int)(unsigned)_c : ts_lo; ts_hi = (lane == nts) ? (int)(unsigned)(_c >> 32) : ts_hi; ++nts; } } while (0)
    PG8_STAMP();
    unsigned voffA[2], voffB[2];
#pragma unroll
    for (int i = 0; i < 2; ++i) { int R, C; stage_rc(tid * 16 + i * 8192, R, C); const int Rb = Epi::PERM ? ((R & ~31) + perm32(R & 31)) : R;
        voffA[i] = (unsigned)(R * K + C) * 2u; voffB[i] = (unsigned)(Rb * K + C) * 2u; }
    const size_t kstep = (size_t)(BK * 2);
    const size_t hstep = (size_t)HALF * K * 2;
    const size_t tstep = 2 * hstep;
    const unsigned ldsw = (unsigned)wid * 1024u;
    const int aoff = lds_byte(wr * 64 + fr, fq * 8), boff = lds_byte(wc * 32 + fr, fq * 8);
#define PG8_SA(b, h) (((b) * 2 + (h)) * HTB)
#define PG8_SB(b, h) ((4 + (b) * 2 + (h)) * HTB)
#define PG8_STAGE(bufoff, gbase, voff) do { _Pragma("unroll") for (int _i = 0; _i < 2; ++_i) \
        __builtin_amdgcn_global_load_lds((const unsigned*)((const char*)(gbase) + (voff)[_i]), (PG8_LAS unsigned*)(lds + (bufoff) + ldsw + _i * 8192), 16, 0, 0); } while (0)
#define PG8_LDA(dst, b, h) do { _Pragma("unroll") for (int m = 0; m < 4; ++m) _Pragma("unroll") for (int k = 0; k < 2; ++k) dst[m][k] = *(const PG8_LAS bf16x8*)(lds + PG8_SA(b, h) + aoff + m * 2048 + k * 1024); } while (0)
#define PG8_LDB(dst, b, h) do { _Pragma("unroll") for (int n = 0; n < 2; ++n) _Pragma("unroll") for (int k = 0; k < 2; ++k) dst[n][k] = *(const PG8_LAS bf16x8*)(lds + PG8_SB(b, h) + boff + n * 2048 + k * 1024); } while (0)
#define PG8_MMA(ai, bj, At, Bt) do { __builtin_amdgcn_s_setprio(1); _Pragma("unroll") for (int m = 0; m < 4; ++m) _Pragma("unroll") for (int n = 0; n < 2; ++n) _Pragma("unroll") for (int k = 0; k < 2; ++k) \
        acc[ai][bj][m][n] = __builtin_amdgcn_mfma_f32_16x16x32_bf16(Bt[n][k], At[m][k], acc[ai][bj][m][n], 0, 0, 0); __builtin_amdgcn_s_setprio(0); } while (0)
#define PG8_WAIT_V(n) asm volatile("s_waitcnt vmcnt(" #n ")" ::: "memory")
#define PG8_WAIT_L(n) asm volatile("s_waitcnt lgkmcnt(" #n ")" ::: "memory")
#define PG8_BAR __builtin_amdgcn_s_barrier()
#define PG8_SCHED __builtin_amdgcn_sched_barrier(0)
    Unit cur, nxt; int ui = 0;
    if (!S.next(0, cur)) return;
    f32x4 acc[2][2][4][2];
#pragma unroll
    for (int a = 0; a < 2; ++a)
#pragma unroll
        for (int b = 0; b < 2; ++b)
#pragma unroll
            for (int m = 0; m < 4; ++m)
#pragma unroll
                for (int n = 0; n < 2; ++n) acc[a][b][m][n] = (f32x4){0.f, 0.f, 0.f, 0.f};
    bf16x8 At[4][2], B0[2][2], B1[2][2];
    const char* cA = (const char*)g.A + (size_t)cur.pm * tstep; const char* cB = (const char*)g.Bt + (size_t)cur.pn * tstep;
    S.a_ready(cur);
    PG8_STAGE(PG8_SB(0, 0), cB, voffB); PG8_STAGE(PG8_SA(0, 0), cA, voffA); PG8_STAGE(PG8_SB(0, 1), cB + hstep, voffB); PG8_STAGE(PG8_SA(0, 1), cA + hstep, voffA);
    if (wr == 1) PG8_BAR;
    PG8_WAIT_V(4); PG8_BAR;
    PG8_STAGE(PG8_SB(1, 0), cB + kstep, voffB); PG8_STAGE(PG8_SA(1, 0), cA + kstep, voffA); PG8_STAGE(PG8_SB(1, 1), cB + hstep + kstep, voffB);
    PG8_WAIT_V(6); PG8_BAR;
    PG8_STAMP();
    for (;;) {
        const bool has_next = S.next(ui + 1, nxt);
        const char* nA = has_next ? (const char*)g.A + (size_t)nxt.pm * tstep : cA; const char* nB = has_next ? (const char*)g.Bt + (size_t)nxt.pn * tstep : cB;
        for (int t = 0; t < nt; t += 2) {
            const bool last = (t == nt - 2);
            const char* a1 = cA + (size_t)(t + 1) * kstep;
            const char* a2 = last ? nA : cA + (size_t)(t + 2) * kstep; const char* b2 = last ? nB : cB + (size_t)(t + 2) * kstep;
            const char* a3 = a2 + kstep; const char* b3 = b2 + kstep;
            if (last && has_next) S.a_ready(nxt);
            PG8_LDB(B0, 0, 0); PG8_SCHED; PG8_LDA(At, 0, 0); PG8_STAGE(PG8_SA(1, 1), a1 + hstep, voffA);
            PG8_WAIT_L(8); PG8_BAR; PG8_WAIT_L(0); PG8_MMA(0, 0, At, B0); PG8_BAR; PG8_SCHED;
            PG8_LDB(B1, 0, 1); PG8_STAGE(PG8_SB(0, 0), b2, voffB);
            PG8_BAR; PG8_WAIT_L(0); PG8_MMA(0, 1, At, B1); PG8_BAR;
            PG8_LDA(At, 0, 1); PG8_STAGE(PG8_SA(0, 0), a2, voffA);
            PG8_BAR; PG8_WAIT_L(0); PG8_MMA(1, 0, At, B0); PG8_BAR; PG8_SCHED;
            PG8_STAGE(PG8_SB(0, 1), b2 + hstep, voffB);
            PG8_WAIT_V(6); PG8_BAR; PG8_MMA(1, 1, At, B1); PG8_BAR;
            PG8_LDB(B0, 1, 0); PG8_SCHED; PG8_LDA(At, 1, 0); PG8_STAGE(PG8_SA(0, 1), a2 + hstep, voffA);
            PG8_WAIT_L(8); PG8_BAR; PG8_WAIT_L(0); PG8_MMA(0, 0, At, B0); PG8_BAR; PG8_SCHED;
            PG8_LDB(B1, 1, 1); PG8_STAGE(PG8_SB(1, 0), b3, voffB);
            PG8_BAR; PG8_WAIT_L(0); PG8_MMA(0, 1, At, B1); PG8_BAR;
            PG8_LDA(At, 1, 1); PG8_STAGE(PG8_SA(1, 0), a3, voffA);
            PG8_BAR; PG8_WAIT_L(0); PG8_MMA(1, 0, At, B0); PG8_BAR; PG8_SCHED;
            PG8_STAGE(PG8_SB(1, 1), b3 + hstep, voffB);
            PG8_WAIT_V(6); PG8_BAR; PG8_MMA(1, 1, At, B1); PG8_BAR;
        }
        PG8_STAMP();
        if constexpr (!Epi::AFTER_DRAIN) { E(acc, cur, wr, wc, fr, fq); S.done(cur); }
        PG8_STAMP();
        if (!has_next) break;
#pragma unroll
        for (int a = 0; a < 2; ++a)
#pragma unroll
            for (int b = 0; b < 2; ++b)
#pragma unroll
                for (int m = 0; m < 4; ++m)
#pragma unroll
                    for (int n = 0; n < 2; ++n) acc[a][b][m][n] = (f32x4){0.f, 0.f, 0.f, 0.f};
        cur = nxt; cA = nA; cB = nB; ++ui;
    }
    PG8_WAIT_V(0);
    if (wr == 0) PG8_BAR;
    PG8_BAR;
    if constexpr (Epi::AFTER_DRAIN) { E.fused(acc, cur, wr, wc, fr, fq, lds, wid, lane); S.done(cur); }
    PG8_STAMP();
    if (STAMP && wid == 0) { stamps[lane] = lane < nts ? (((unsigned long long)(unsigned)ts_hi << 32) | (unsigned)ts_lo) : 0ull;
        if (lane == 62) stamps[62] = rt_entry; if (lane == 63) stamps[63] = (unsigned long long)wall_clock64(); }
#undef PG8_STAMP
#undef PG8_SA
#undef PG8_SB
#undef PG8_STAGE
#undef PG8_LDA
#undef PG8_LDB
#undef PG8_MMA
#undef PG8_WAIT_V
#undef PG8_WAIT_L
#undef PG8_BAR
#undef PG8_SCHED
}
}

namespace pg8 {
struct SchedPlain {
    int nM, nN, G, c;
    __device__ void init(int M, int N, int G_, int c_) { nM = M / BM; nN = N / BM; G = G_; c = c_; }
    __device__ bool next(int i, Unit& u) const { const int L = i * G + c; if (L >= nM * nN) return false; u.pm = L % nM; u.pn = L / nM; u.aux = 0; return true; }
    __device__ __forceinline__ void a_ready(const Unit&) const {}
    __device__ __forceinline__ void done(const Unit&) const {}
};
struct SchedMerge {
    int nMr, G, c;
    __device__ bool next(int i, Unit& u) const { const int tile = (i / 3) * G + c, nb = i % 3; if (tile >= nMr * 4) return false; u.pm = nb * nMr + tile % nMr; u.pn = nb * 4 + tile / nMr; u.aux = nb; return true; }
    __device__ __forceinline__ void a_ready(const Unit&) const {}
    __device__ __forceinline__ void done(const Unit&) const {}
};
struct SchedMoe1 {
    const int* tile_exp; int t0, nt, G, c;
    __device__ bool next(int i, Unit& u) const { const int L = i * G + c; if (L >= nt * 28) return false; const int t = t0 + L % nt, j = L / nt; u.pm = t; u.pn = tile_exp[t] * 28 + j; u.aux = j; return true; }
    __device__ __forceinline__ void a_ready(const Unit&) const {}
    __device__ __forceinline__ void done(const Unit&) const {}
};
struct SchedMoe2 {
    const int* tile_exp; int t0, nt, G, c;
    __device__ bool next(int i, Unit& u) const { const int L = i * G + c; if (L >= nt * 4) return false; const int tl = L % nt, j = L / nt; u.pm = tl; u.pn = tile_exp[t0 + tl] * 4 + j; u.aux = (t0 + tl) * 4 + j; return true; }
    __device__ __forceinline__ void a_ready(const Unit&) const {}
    __device__ __forceinline__ void done(const Unit&) const {}
};

struct EpiStoreBf16 {
    static constexpr bool PERM = true, AFTER_DRAIN = false;
    bf16_t* O; int ldc; int mode;
    __device__ __forceinline__ void operator()(const f32x4 (&acc)[2][2][4][2], const Unit& u, int wr, int wc, int fr, int fq) const {
        const int rt = mode ? (u.aux >> 2) : u.pm, ct = mode ? (u.aux & 3) : u.pn;
        const int row0 = rt * BM + wr * 64 + fr, col0 = ct * BM + wc * 32 + 8 * fq;
#pragma unroll
        for (int ai = 0; ai < 2; ++ai)
#pragma unroll
            for (int m = 0; m < 4; ++m) { bf16_t* rowp = O + (size_t)(row0 + ai * HALF + m * 16) * ldc + col0;
#pragma unroll
                for (int bj = 0; bj < 2; ++bj) { const f32x4 v0 = acc[ai][bj][m][0], v1 = acc[ai][bj][m][1];
                    u32x4 w; w.x = cvt_pk_bf16(v0[0], v0[1]); w.y = cvt_pk_bf16(v0[2], v0[3]); w.z = cvt_pk_bf16(v1[0], v1[1]); w.w = cvt_pk_bf16(v1[2], v1[3]);
                    *(u32x4*)(rowp + bj * HALF) = w; } }
    }
};
struct EpiSwiGLU {
    static constexpr bool PERM = true, AFTER_DRAIN = false;
    bf16_t* O; int ldc; int mode; int t0;
    __device__ __forceinline__ void operator()(const f32x4 (&acc)[2][2][4][2], const Unit& u, int wr, int wc, int fr, int fq) const {
        const int rt = mode ? (u.pm - t0) : u.pm, ct = mode ? u.aux : u.pn;
        const int row0 = rt * BM + wr * 64 + fr, col0 = ct * HALF + wc * 32 + 8 * fq;
#pragma unroll
        for (int ai = 0; ai < 2; ++ai)
#pragma unroll
            for (int m = 0; m < 4; ++m) { bf16_t* rowp = O + (size_t)(row0 + ai * HALF + m * 16) * ldc + col0;
                float h[8];
#pragma unroll
                for (int n = 0; n < 2; ++n)
#pragma unroll
                    for (int j = 0; j < 4; ++j) { const float a = acc[ai][0][m][n][j], g = acc[ai][1][m][n][j]; h[n * 4 + j] = a / (1.0f + __expf(-a)) * g; }
                u32x4 w; w.x = cvt_pk_bf16(h[0], h[1]); w.y = cvt_pk_bf16(h[2], h[3]); w.z = cvt_pk_bf16(h[4], h[5]); w.w = cvt_pk_bf16(h[6], h[7]);
                *(u32x4*)rowp = w; }
    }
};
struct EpiStoreF32 {
    static constexpr bool PERM = false, AFTER_DRAIN = false;
    float* C; int ldc;
    __device__ __forceinline__ void operator()(const f32x4 (&acc)[2][2][4][2], const Unit& u, int wr, int wc, int fr, int fq) const {
        const int row0 = u.pm * BM + wr * 64 + fr, col0 = u.pn * BM + wc * 32 + 4 * fq;
#pragma unroll
        for (int ai = 0; ai < 2; ++ai)
#pragma unroll
            for (int m = 0; m < 4; ++m) { float* rowp = C + (size_t)(row0 + ai * HALF + m * 16) * ldc + col0;
#pragma unroll
                for (int bj = 0; bj < 2; ++bj)
#pragma unroll
                    for (int n = 0; n < 2; ++n) *(f32x4*)(rowp + bj * HALF + n * 16) = acc[ai][bj][m][n]; }
    }
};
struct EpiMerge {
    static constexpr bool PERM = true, AFTER_DRAIN = false;
    const bf16_t* gate; int ldg;
    float* part; bf16_t* merged; int nMr;
    __device__ __forceinline__ void operator()(const f32x4 (&acc)[2][2][4][2], const Unit& u, int wr, int wc, int fr, int fq) const {
        const int nb = u.aux, rt = u.pm - nb * nMr, ct = u.pn - nb * 4;
        const int row0 = rt * BM + wr * 64 + fr, col0 = ct * BM + wc * 32 + 8 * fq;
#pragma unroll
        for (int ai = 0; ai < 2; ++ai)
#pragma unroll
            for (int m = 0; m < 4; ++m) { const size_t row = (size_t)(row0 + ai * HALF + m * 16);
#pragma unroll
                for (int bj = 0; bj < 2; ++bj) { const int col = col0 + bj * HALF;
                    const u32x4 gw = *(const u32x4*)(gate + row * ldg + nb * 1024 + col);
                    float g[8]; g[0] = __uint_as_float(gw.x << 16); g[1] = __uint_as_float(gw.x & 0xffff0000u); g[2] = __uint_as_float(gw.y << 16); g[3] = __uint_as_float(gw.y & 0xffff0000u);
                    g[4] = __uint_as_float(gw.z << 16); g[5] = __uint_as_float(gw.z & 0xffff0000u); g[6] = __uint_as_float(gw.w << 16); g[7] = __uint_as_float(gw.w & 0xffff0000u);
                    float v[8];
#pragma unroll
                    for (int n = 0; n < 2; ++n)
#pragma unroll
                        for (int j = 0; j < 4; ++j) v[n * 4 + j] = acc[ai][bj][m][n][j] / (1.0f + __expf(-g[n * 4 + j]));
                    float* pp = part + row * 1024 + col;
                    if (nb > 0) { const f32x4 p0 = *(const f32x4*)pp, p1 = *(const f32x4*)(pp + 4);
#pragma unroll
                        for (int j = 0; j < 4; ++j) { v[j] += p0[j]; v[4 + j] += p1[j]; } }
                    if (nb < 2) { *(f32x4*)pp = (f32x4){v[0], v[1], v[2], v[3]}; *(f32x4*)(pp + 4) = (f32x4){v[4], v[5], v[6], v[7]}; }
                    else { u32x4 w; w.x = cvt_pk_bf16(v[0], v[1]); w.y = cvt_pk_bf16(v[2], v[3]); w.z = cvt_pk_bf16(v[4], v[5]); w.w = cvt_pk_bf16(v[6], v[7]);
                        *(u32x4*)(merged + row * 1024 + col) = w; } } }
    }
};
}
#define XB_TMO      128
#define XB_XCNT(j)  (256  + 64 * (j))
#define XB_XSUB(j)  (1280 + 64 * (j))
#define XB_XGEN(j)  (2304 + 64 * (j))
#define XB_TOP      3328
#define XB_TOPGEN   3392
#define XCD_BAR_WORDS 3456
#define XB_SPIN_CAP (1u << 18)

__device__ __forceinline__ unsigned xb_ld(unsigned* p)              { return __hip_atomic_load(p, __ATOMIC_RELAXED, __HIP_MEMORY_SCOPE_AGENT); }
__device__ __forceinline__ unsigned xb_add(unsigned* p, unsigned v) { return __hip_atomic_fetch_add(p, v, __ATOMIC_RELAXED, __HIP_MEMORY_SCOPE_AGENT); }
__device__ __forceinline__ unsigned xb_xcc_id() { return (unsigned)__builtin_amdgcn_s_getreg((3 << 11) | 20) & 0xFu; }
#define XB_SPIN(cond, bar) do { unsigned _sp = 0; while (cond) { __builtin_amdgcn_s_sleep(1); \
    if ((++_sp & 255u) == 0u) { if (xb_ld(&(bar)[XB_TMO])) break; if (_sp > XB_SPIN_CAP) { atomicAdd(&(bar)[XB_TMO], 1u); break; } } } } while (0)

struct XcdBarrier {
    unsigned* bar; unsigned x;
    volatile LAS unsigned* st;
};

__device__ __forceinline__ XcdBarrier xcd_barrier_post(unsigned* bar, volatile LAS unsigned* st) {
    XcdBarrier b; b.bar = bar; b.x = xb_xcc_id(); b.st = st;
    if (threadIdx.x == 0) (void)xb_add(&bar[XB_XCNT(b.x)], 1u);
    return b;
}
__device__ __forceinline__ void xcd_barrier_complete(unsigned* bar, unsigned x, unsigned& nloc, unsigned& nx) {
    const unsigned G = gridDim.x * gridDim.y * gridDim.z;
    unsigned sum, cnt, mine, sp = 0u;
    for (;;) {
        sum = 0u; cnt = 0u; mine = 0u;
#pragma unroll
        for (unsigned j = 0; j < 16; ++j) { const unsigned c = xb_ld(&bar[XB_XCNT(j)]); sum += c; cnt += (c > 0u) ? 1u : 0u; mine = (j == x) ? c : mine; }
        if (sum == G) break;
        __builtin_amdgcn_s_sleep(1);
        if ((++sp & 255u) == 0u) { if (xb_ld(&bar[XB_TMO])) break; if (sp > XB_SPIN_CAP) { atomicAdd(&bar[XB_TMO], 1u); break; } }
    }
    nloc = mine > 0u ? mine : 1u; nx = cnt > 0u ? cnt : 1u;
}

__device__ __forceinline__ void xcd_barrier(const XcdBarrier& b) {
    asm volatile("s_waitcnt vmcnt(0)" ::: "memory");
    __syncthreads();
    if (threadIdx.x == 0) {
        unsigned* bar = b.bar;
        __builtin_amdgcn_s_waitcnt(0);
        unsigned nloc = b.st[0], nx = b.st[1];
        if (nloc == 0u) { xcd_barrier_complete(bar, b.x, nloc, nx); b.st[0] = nloc; b.st[1] = nx; }
        const unsigned old = xb_add(&bar[XB_XSUB(b.x)], 1u);
        const unsigned gen = old / nloc;
        if (old + 1u == (gen + 1u) * nloc) {
            __builtin_amdgcn_fence(__ATOMIC_RELEASE, "agent");
            asm volatile("s_waitcnt vmcnt(0)" ::: "memory");
            const unsigned og = xb_add(&bar[XB_TOP], 1u);
            const unsigned tg = og / nx;
            if (og + 1u == (tg + 1u) * nx) xb_add(&bar[XB_TOPGEN], 1u);
            else XB_SPIN(xb_ld(&bar[XB_TOPGEN]) == tg, bar);
            __builtin_amdgcn_fence(__ATOMIC_ACQUIRE, "agent");
            xb_add(&bar[XB_XGEN(b.x)], 1u);
            asm volatile("s_waitcnt vmcnt(0)" ::: "memory");
        } else {
            XB_SPIN(xb_ld(&bar[XB_XGEN(b.x)]) == gen, bar);
            __builtin_amdgcn_fence(__ATOMIC_ACQUIRE, "agent");
            asm volatile("s_waitcnt vmcnt(0)" ::: "memory");
        }
    }
    __syncthreads();
}

struct Ctx {
    const float* in[25]; float* out; unsigned char* ws;
    unsigned char* lds;
    int tid, lane, wave, wg, G;
};
#define IN_X 0
#define IN_C 1
#define IN_POS 2
#define IN_ADALN_W 3
#define IN_ADALN_B 4
#define IN_NORM_W 5
#define IN_W_IN 6
#define IN_GLA_UP 7
#define IN_GLA_BIAS 8
#define IN_GLA_NORM 9
#define IN_DIFF_LAMBDA 10
#define IN_DIFF_NORM 11
#define IN_GDN_CONV 12
#define IN_GDN_ALOG 13
#define IN_GDN_DTB 14
#define IN_GDN_NORM 15
#define IN_W_BRANCH 16
#define IN_W_OUT 17
#define IN_FFN_W1 18
#define IN_FFN_W3 19
#define IN_FFN_W2 20
#define IN_ROUTER 21
#define IN_MOE_W1 22
#define IN_MOE_W3 23
#define IN_MOE_W2 24

__device__ __forceinline__ void tr_item(const float* W, int K, int N, bf16* WT, int drow, float* scr, int k0, int n0, int lane) {
#pragma unroll 8
    for (int i = 0; i < 32; ++i) { const int kk = 2 * i + (lane >> 5); const int n = n0 + (lane & 31);
        scr[kk * 33 + (lane & 31)] = (n < N) ? W[(size_t)(k0 + kk) * N + n] : 0.f; }
    asm volatile("s_waitcnt lgkmcnt(0)" ::: "memory");
    const int c = lane & 7;
#pragma unroll
    for (int j = 0; j < 4; ++j) { const int n = (lane >> 3) + 8 * j; const float* s = scr + (8 * c) * 33 + n;
        u32x4 o; o.x = cvtpk(s[0 * 33], s[1 * 33]); o.y = cvtpk(s[2 * 33], s[3 * 33]); o.z = cvtpk(s[4 * 33], s[5 * 33]); o.w = cvtpk(s[6 * 33], s[7 * 33]);
        *(u32x4*)(WT + (size_t)(drow + n) * K + k0 + 8 * c) = o; }
    asm volatile("s_waitcnt lgkmcnt(0)" ::: "memory");
}
__device__ __forceinline__ void tr_matrix(Ctx& C, const float* W, int K, int N, int Npad, bf16* WT, int drow0, bool swi, int& base) {
    float* scr = (float*)(C.lds + C.wave * 8704);
    const int nblk = Npad / 32, nitems = (K / 64) * nblk, gw = C.wg * NWAVES + C.wave, NGW = C.G * NWAVES;
    int first = (gw - base % NGW + NGW) % NGW;
    for (int it = first; it < nitems; it += NGW) { const int kb = it / nblk, nb = it % nblk, n0 = nb * 32;
        const int drow = drow0 + (swi ? (n0 / 128) * 256 + (n0 % 128) : n0);
        tr_item(W, K, N, WT, drow, scr, kb * 64, n0, C.lane); }
    base += nitems;
}
__device__ __forceinline__ void convert_mixer_weights(Ctx& C, int l, int& base) {
    tr_matrix(C, C.in[IN_W_IN] + (size_t)l * DM * INC, DM, INC, LDP, (bf16*)(C.ws + WS_WIN), 0, false, base);
    for (int nb = 0; nb < 3; ++nb) tr_matrix(C, C.in[IN_W_BRANCH] + (size_t)(l * 3 + nb) * 512 * DM, 512, DM, DM, (bf16*)(C.ws + WS_WB) + (size_t)nb * 1024 * 512, 0, false, base);
    tr_matrix(C, C.in[IN_W_OUT] + (size_t)l * DM * DM, DM, DM, DM, (bf16*)(C.ws + WS_WO), 0, false, base);
}
__device__ __forceinline__ void convert_ffn_weights(Ctx& C, int& base) {
    tr_matrix(C, C.in[IN_FFN_W1], DM, DFF, DFF, (bf16*)(C.ws + WS_W13), 0, true, base);
    tr_matrix(C, C.in[IN_FFN_W3], DM, DFF, DFF, (bf16*)(C.ws + WS_W13), 128, true, base);
    tr_matrix(C, C.in[IN_FFN_W2], DFF, DM, DM, (bf16*)(C.ws + WS_W2), 0, false, base);
}
__device__ __forceinline__ void convert_moe_weights(Ctx& C, int& base) {
    for (int e = 0; e < NEXP; ++e) {
        tr_matrix(C, C.in[IN_MOE_W1] + (size_t)e * DM * DEXP, DM, DEXP, DEXP, (bf16*)(C.ws + WS_MW13) + (size_t)e * 2 * DEXP * DM, 0, true, base);
        tr_matrix(C, C.in[IN_MOE_W3] + (size_t)e * DM * DEXP, DM, DEXP, DEXP, (bf16*)(C.ws + WS_MW13) + (size_t)e * 2 * DEXP * DM, 128, true, base);
        tr_matrix(C, C.in[IN_MOE_W2] + (size_t)e * DEXP * DM, DEXP, DM, DM, (bf16*)(C.ws + WS_MW2) + (size_t)e * DM * DEXP, 0, false, base);
    }
}

__device__ __forceinline__ void mod_partials(Ctx& C) {
    float* sm = (float*)(C.lds + 8 * 8704);
    float* modp = (float*)(C.ws + WS_MODP);
    for (int item = C.wg; item < 192; item += C.G) {
        const int l = item / 96, r = item % 96, ec = r / 8, dp = r % 8;
        __syncthreads();
        { const int b = C.tid >> 7, dd = C.tid & 127; const float cv = C.in[IN_C][b * DM + dp * 128 + dd]; sm[C.tid] = cv / (1.0f + __expf(-cv)); }
        __syncthreads();
        const int e = ec * 512 + C.tid; float a0 = 0.f, a1 = 0.f, a2 = 0.f, a3 = 0.f;
        const float* wp = C.in[IN_ADALN_W] + ((size_t)l * DM + dp * 128) * 6144 + e;
#pragma unroll 8
        for (int dd = 0; dd < 128; ++dd) { const float w = wp[(size_t)dd * 6144]; a0 += sm[dd] * w; a1 += sm[128 + dd] * w; a2 += sm[256 + dd] * w; a3 += sm[384 + dd] * w; }
        float* o = modp + ((size_t)(dp * 2 + l) * 4) * 6144 + e;
        o[0] = a0; o[6144] = a1; o[2 * 6144] = a2; o[3 * 6144] = a3;
    }
}
__device__ __forceinline__ float mod_val(const Ctx& C, int l, int b, int k, int c) {
    const float* modp = (const float*)(C.ws + WS_MODP);
    float s = C.in[IN_ADALN_B][l * 6144 + k * 1024 + c];
#pragma unroll
    for (int dp = 0; dp < 8; ++dp) s += modp[((size_t)(dp * 2 + l) * 4 + b) * 6144 + k * 1024 + c];
    return s;
}

__device__ __forceinline__ void phase_norm_in(Ctx& C, const float* x, int l) {
    float* vA = (float*)C.lds; float* vB = vA + 1024;
    const int rows_per_wg = TOK / C.G;
    const int r0 = C.wg * rows_per_wg, b = r0 / SEQ;
    __syncthreads();
    for (int c = C.tid; c < DM; c += NTHREADS) { vA[c] = C.in[IN_NORM_W][(l * 4 + 0) * DM + c] * (1.0f + mod_val(C, l, b, 1, c)); vB[c] = mod_val(C, l, b, 0, c); }
    __syncthreads();
    bf16* H = (bf16*)(C.ws + WS_H);
    for (int r = r0 + C.wave; r < r0 + rows_per_wg; r += NWAVES) {
        const f32x4* xr = (const f32x4*)(x + (size_t)r * DM) + C.lane; f32x4 v[4]; float s = 0.f;
#pragma unroll
        for (int j = 0; j < 4; ++j) { v[j] = xr[64 * j]; s += v[j].x * v[j].x + v[j].y * v[j].y + v[j].z * v[j].z + v[j].w * v[j].w; }
        const float rs = rsqrtf(wave_sum(s) * (1.0f / DM) + EPS);
        u32x2* o = (u32x2*)(H + (size_t)r * DM) + C.lane;
#pragma unroll
        for (int j = 0; j < 4; ++j) { const int c = 4 * C.lane + 256 * j; const f32x4 a = *(const f32x4*)(vA + c), bb = *(const f32x4*)(vB + c);
            u32x2 w; w.x = cvtpk(v[j].x * rs * a.x + bb.x, v[j].y * rs * a.y + bb.y); w.y = cvtpk(v[j].z * rs * a.z + bb.z, v[j].w * rs * a.w + bb.w); o[64 * j] = w; }
    }
}
__device__ __forceinline__ void phase_resnorm(Ctx& C, int row_lo, int nrows, const float* xold, const float* ysrc, int yrow0, bool from_slots,
                                              int l, int kg, int nwres, bool do_h, int ln, int ksc, int ksh, int nwn, bool do_route, int grp0) {
    float* vG = (float*)C.lds; float* vA = vG + 1024; float* vB = vA + 1024; float* Wr = vB + 1024;
    int* cnt = (int*)(Wr + 8192);
    const int rows_per_wg = nrows / C.G, r0 = row_lo + C.wg * rows_per_wg, b = r0 / SEQ;
    __syncthreads();
    for (int c = C.tid; c < DM; c += NTHREADS) {
        vG[c] = mod_val(C, l, b, kg, c) * C.in[IN_NORM_W][(l * 4 + nwres) * DM + c];
        if (do_h) { vA[c] = C.in[IN_NORM_W][(ln * 4 + nwn) * DM + c] * (1.0f + mod_val(C, ln, b, ksc, c)); vB[c] = mod_val(C, ln, b, ksh, c); } }
    if (do_route) { for (int i = C.tid; i < DM * NEXP; i += NTHREADS) Wr[i] = C.in[IN_ROUTER][i]; if (C.tid < 8) cnt[C.tid] = 0; }
    __syncthreads();
    bf16* H = (bf16*)(C.ws + WS_H);
    const uint4* route = (const uint4*)(C.ws + WS_ROUTE); const int* slotrow = (const int*)(C.ws + WS_SLOTROW); const bf16* ys = (const bf16*)(C.ws + WS_ASORT);
    for (int r = r0 + C.wave; r < r0 + rows_per_wg; r += NWAVES) {
        f32x4 y[4]; float s = 0.f;
        if (!from_slots) { const f32x4* yr = (const f32x4*)(ysrc + (size_t)(r - yrow0) * DM) + C.lane;
#pragma unroll
            for (int j = 0; j < 4; ++j) y[j] = yr[64 * j]; }
        else { const uint4 rt = route[r]; const float w0 = __uint_as_float(rt.z), w1 = __uint_as_float(rt.w);
            const u32x2* y0 = (const u32x2*)(ys + (size_t)slotrow[2 * r] * DM) + C.lane; const u32x2* y1 = (const u32x2*)(ys + (size_t)slotrow[2 * r + 1] * DM) + C.lane;
#pragma unroll
            for (int j = 0; j < 4; ++j) { const u32x2 a = y0[64 * j], bb = y1[64 * j];
                y[j].x = w0 * bflo(a.x) + w1 * bflo(bb.x); y[j].y = w0 * bfhi(a.x) + w1 * bfhi(bb.x); y[j].z = w0 * bflo(a.y) + w1 * bflo(bb.y); y[j].w = w0 * bfhi(a.y) + w1 * bfhi(bb.y); } }
#pragma unroll
        for (int j = 0; j < 4; ++j) s += y[j].x * y[j].x + y[j].y * y[j].y + y[j].z * y[j].z + y[j].w * y[j].w;
        const float rs = rsqrtf(wave_sum(s) * (1.0f / DM) + EPS);
        const f32x4* xr = (const f32x4*)(xold + (size_t)r * DM) + C.lane; f32x4* xo = (f32x4*)(C.out + (size_t)r * DM) + C.lane;
        f32x4 xn[4]; float s2 = 0.f;
#pragma unroll
        for (int j = 0; j < 4; ++j) { const int c = 4 * C.lane + 256 * j; const f32x4 g = *(const f32x4*)(vG + c); const f32x4 xv = xr[64 * j];
            xn[j].x = xv.x + g.x * (y[j].x * rs); xn[j].y = xv.y + g.y * (y[j].y * rs); xn[j].z = xv.z + g.z * (y[j].z * rs); xn[j].w = xv.w + g.w * (y[j].w * rs);
            xo[64 * j] = xn[j]; s2 += xn[j].x * xn[j].x + xn[j].y * xn[j].y + xn[j].z * xn[j].z + xn[j].w * xn[j].w; }
        if (do_h) {
            const float rs2 = rsqrtf(wave_sum(s2) * (1.0f / DM) + EPS);
            u32x2* o = (u32x2*)(H + (size_t)r * DM) + C.lane; float lg[8];
#pragma unroll
            for (int e = 0; e < 8; ++e) lg[e] = 0.f;
#pragma unroll
            for (int j = 0; j < 4; ++j) { const int c = 4 * C.lane + 256 * j; const f32x4 a = *(const f32x4*)(vA + c), bb = *(const f32x4*)(vB + c);
                float hv[4]; hv[0] = xn[j].x * rs2 * a.x + bb.x; hv[1] = xn[j].y * rs2 * a.y + bb.y; hv[2] = xn[j].z * rs2 * a.z + bb.z; hv[3] = xn[j].w * rs2 * a.w + bb.w;
                u32x2 w; w.x = cvtpk(hv[0], hv[1]); w.y = cvtpk(hv[2], hv[3]); o[64 * j] = w;
                if (do_route) {
#pragma unroll
                    for (int q = 0; q < 4; ++q) { const f32x4 wa = *(const f32x4*)(Wr + (c + q) * 8), wb = *(const f32x4*)(Wr + (c + q) * 8 + 4);
                        lg[0] += hv[q] * wa.x; lg[1] += hv[q] * wa.y; lg[2] += hv[q] * wa.z; lg[3] += hv[q] * wa.w; lg[4] += hv[q] * wb.x; lg[5] += hv[q] * wb.y; lg[6] += hv[q] * wb.z; lg[7] += hv[q] * wb.w; } } }
            if (do_route) {
#pragma unroll
                for (int e = 0; e < 8; ++e) lg[e] = wave_sum(lg[e]);
                int i0 = 0; float v0 = lg[0];
#pragma unroll
                for (int e = 1; e < 8; ++e) if (lg[e] > v0) { v0 = lg[e]; i0 = e; }
                int i1 = -1; float v1 = -3.0e38f;
#pragma unroll
                for (int e = 0; e < 8; ++e) if (e != i0 && lg[e] > v1) { v1 = lg[e]; i1 = e; }
                const float w0 = 1.0f / (1.0f + __expf(v1 - v0)), w1 = 1.0f - w0;
                if (C.lane == 0) { const int p0 = atomicAdd(&cnt[i0], 1), p1 = atomicAdd(&cnt[i1], 1);
                    ((uint4*)(C.ws + WS_ROUTE))[r] = make_uint4((unsigned)i0, (unsigned)i1, __float_as_uint(w0), __float_as_uint(w1));
                    int* lpos = (int*)(C.ws + WS_LPOS); lpos[2 * r] = p0; lpos[2 * r + 1] = p1; }
            }
        }
    }
    if (do_route) { __syncthreads(); if (C.tid < 8) ((int*)(C.ws + WS_GCNT))[(grp0 + C.wg) * 8 + C.tid] = cnt[C.tid]; }
}

__device__ __forceinline__ void phase_postproj(Ctx& C, int hb, int l) {
    float* cw = (float*)C.lds;
    __syncthreads();
    for (int i = C.tid; i < 4 * 1536; i += NTHREADS) cw[i] = C.in[IN_GDN_CONV][l * 4 * 1536 + i];
    __syncthreads();
    bf16* proj = (bf16*)(C.ws + WS_PROJ); bf16* qkvc = (bf16*)(C.ws + WS_QKVC); float* gate = (float*)(C.ws + WS_GATE);
    const int tpw = HBR / (C.G * NWAVES);
    const int gw = C.wg * NWAVES + C.wave, lane = C.lane;
    const float inv_f = __expf(-13.122363377404328f * (float)(lane & 7) * 0.125f);
    for (int tk = 0; tk < tpw; ++tk) {
        const int r = gw * tpw + tk, grow = hb * HBR + r, tpos = grow % SEQ;
#pragma unroll
        for (int p = 0; p < 3; ++p) {
            const int c0 = p * 512 + lane * 8; float acc[8];
#pragma unroll
            for (int i = 0; i < 8; ++i) acc[i] = 0.f;
#pragma unroll
            for (int j = 0; j < 4; ++j) { const int tt = tpos - 1 + j;
                if (tt >= 0 && tt < SEQ) { const u32x4 w = *(const u32x4*)(proj + (size_t)(r - 1 + j) * LDP + C_NQ + c0); float xv[8]; unpack8(w, xv);
                    const f32x4 wa = *(const f32x4*)(cw + j * 1536 + c0), wb = *(const f32x4*)(cw + j * 1536 + c0 + 4);
                    acc[0] += wa.x * xv[0]; acc[1] += wa.y * xv[1]; acc[2] += wa.z * xv[2]; acc[3] += wa.w * xv[3]; acc[4] += wb.x * xv[4]; acc[5] += wb.y * xv[5]; acc[6] += wb.z * xv[6]; acc[7] += wb.w * xv[7]; } }
            float ss = 0.f;
#pragma unroll
            for (int i = 0; i < 8; ++i) { acc[i] = siluf_(acc[i]); ss += acc[i] * acc[i]; }
            if (p < 2) { ss = grp16_sum(ss); const float sc = rsqrtf(ss + EPS) * (p == 0 ? 0.08838834764831845f : 1.0f);
#pragma unroll
                for (int i = 0; i < 8; ++i) acc[i] *= sc; }
            *(u32x4*)(qkvc + (size_t)r * 1536 + c0) = pack8(acc);
        }
        { const float pos = (float)((const int*)C.in[IN_POS])[grow]; float sn, cs; sincosf(pos * inv_f, &sn, &cs);
            bf16* hp = proj + (size_t)r * LDP + (lane < 8 ? C_DQ + lane * 64 : C_DK + (lane & 7) * 64);
            u32x4 w0 = (u32x4){0, 0, 0, 0}, w1 = (u32x4){0, 0, 0, 0};
            if (lane < 16) { w0 = *(const u32x4*)hp; w1 = *(const u32x4*)(hp + 8); }
            float x1[8], x2[8], o1[8], o2[8]; unpack8(w0, x1); unpack8(w1, x2);
#pragma unroll
            for (int i = 0; i < 8; ++i) { const float c_ = __shfl(cs, i), s_ = __shfl(sn, i); o1[i] = x1[i] * c_ - x2[i] * s_; o2[i] = x2[i] * c_ + x1[i] * s_; }
            if (lane < 16) { *(u32x4*)hp = pack8(o1); *(u32x4*)(hp + 8) = pack8(o2); } }
        if (lane < 16) { const int kind = lane >> 2, hh = lane & 3; const float v = bf2f(proj[(size_t)r * LDP + C_NBF + lane]);
            float o; int slot;
            if (kind < 2) { o = sigmoidf_(v); slot = (kind == 0 ? 4 : 12) + hh; }
            else { const int d = kind - 2; const float z = v + C.in[IN_GDN_DTB][(l * 2 + d) * 4 + hh]; const float sp = z > 20.f ? z : log1pf(__expf(z));
                o = -__expf(C.in[IN_GDN_ALOG][(l * 2 + d) * 4 + hh]) * sp; slot = (d == 0 ? 0 : 8) + hh; }
            gate[(size_t)r * 16 + slot] = o; }
    }
}

__device__ __forceinline__ void phase_finalize(Ctx& C, int l) {
    const bf16* proj = (const bf16*)(C.ws + WS_PROJ); bf16* ys = (bf16*)(C.ws + WS_YS);
    const int tpw = HBR / (C.G * NWAVES), gw = C.wg * NWAVES + C.wave, lane = C.lane, c0 = lane * 8;
    for (int tk = 0; tk < tpw; ++tk) { const int r = gw * tpw + tk;
#pragma unroll
        for (int br = 0; br < 2; ++br) {
            const float* of = (const float*)(C.ws + (br == 0 ? WS_OGLA : WS_OGDN)) + (size_t)r * 512 + c0; const float* ob = of + (size_t)HBR * 512;
            const float* nw = C.in[br == 0 ? IN_GLA_NORM : IN_GDN_NORM] + l * 128 + (c0 & 127);
            const f32x4 a0 = *(const f32x4*)of, a1 = *(const f32x4*)(of + 4), b0 = *(const f32x4*)ob, b1 = *(const f32x4*)(ob + 4);
            float o[8]; o[0] = a0.x + b0.x; o[1] = a0.y + b0.y; o[2] = a0.z + b0.z; o[3] = a0.w + b0.w; o[4] = a1.x + b1.x; o[5] = a1.y + b1.y; o[6] = a1.z + b1.z; o[7] = a1.w + b1.w;
            float ss = 0.f;
#pragma unroll
            for (int i = 0; i < 8; ++i) ss += o[i] * o[i];
            const float rs = rsqrtf(grp16_sum(ss) * (1.0f / 128.0f) + EPS);
            const u32x4 gw_ = *(const u32x4*)(proj + (size_t)r * LDP + (br == 0 ? C_GR : C_NZ) + c0); float gz[8]; unpack8(gw_, gz);
            float yv[8];
#pragma unroll
            for (int i = 0; i < 8; ++i) yv[i] = o[i] * rs * nw[i] * siluf_(gz[i]);
            *(u32x4*)(ys + ((size_t)(br == 0 ? 0 : 2) * HBR + r) * 512 + c0) = pack8(yv);
        }
    }
}

__device__ __forceinline__ void gla_unit(Ctx& C, int unit, int l) {
    const int sl = unit & 15, dir = (unit >> 4) & 1, h = (unit >> 5) & 3, sq = unit >> 7;
    const bf16* proj = (const bf16*)(C.ws + WS_PROJ) + (size_t)sq * SEQ * LDP;
    float* og = (float*)(C.ws + WS_OGLA) + ((size_t)dir * HBR + (size_t)sq * SEQ) * 512 + h * 128 + sl * 8;
    float* up = (float*)C.lds;
    float* bs = up + 1024;
    float* obuf = bs + 64;
    float* buf = obuf + 512;
    constexpr int BUFF = 3 * 4096 + 512;
    const int tid = C.tid, lane = C.lane, wv = C.wave;
    __syncthreads();
    for (int i = tid; i < 1024; i += NTHREADS) up[i] = C.in[IN_GLA_UP][((size_t)(l * 2 + dir) * 16 + (i >> 6)) * 256 + h * 64 + (i & 63)];
    if (tid < 64) bs[tid] = C.in[IN_GLA_BIAS][(l * 2 + dir) * 256 + h * 64 + tid];
    __syncthreads();
    const int lr = tid >> 3, lc = (tid & 7) * 8;
    u32x4 rq, rk, rg0, rg1, rv;
    auto issue = [&](int n) {
        const int cn = dir ? 127 - n : n, row = cn * 64 + (dir ? 63 - lr : lr); const bf16* p = proj + (size_t)row * LDP;
        rq = *(const u32x4*)(p + C_GQ + h * 64 + lc); rk = *(const u32x4*)(p + C_GK + h * 64 + lc);
        rg0 = *(const u32x4*)(p + (dir ? C_GWB : C_GWF)); rg1 = *(const u32x4*)(p + (dir ? C_GWB : C_GWF) + 8);
        if (tid < 64) { const int row2 = cn * 64 + (dir ? 63 - tid : tid); rv = *(const u32x4*)(proj + (size_t)row2 * LDP + C_GV + h * 128 + sl * 8); }
    };
    auto commit = [&](int b) {
        float* q = buf + b * BUFF; float* k = q + 4096; float* a = k + 4096; float* v = a + 4096;
        float xq[8], xk[8], g[16]; unpack8(rq, xq); unpack8(rk, xk); unpack8(rg0, g); unpack8(rg1, g + 8);
#pragma unroll
        for (int i = 0; i < 8; ++i) { q[lr * 64 + lc + i] = xq[i] * 0.125f; k[lr * 64 + lc + i] = xk[i];
            float z = bs[lc + i];
#pragma unroll
            for (int r = 0; r < 16; ++r) z += g[r] * up[r * 64 + lc + i];
            const float ls = (z < 0.f ? z : 0.f) - log1pf(__expf(-fabsf(z)));
            a[lr * 64 + lc + i] = __expf(ls * 0.0625f); }
        if (tid < 64) { float xv[8]; unpack8(rv, xv);
#pragma unroll
            for (int i = 0; i < 8; ++i) v[tid * 8 + i] = xv[i]; }
    };
    float S = 0.f;
    issue(0); commit(0); __syncthreads();
    for (int n = 0; n < 128; ++n) {
        const int b = n & 1;
        if (n + 1 < 128) issue(n + 1);
        const float* q = buf + b * BUFF; const float* k = q + 4096; const float* a = k + 4096; const float* v = a + 4096;
        float oreg = 0.f;
#pragma unroll 4
        for (int i = 0; i < 64; ++i) { const float vv = v[i * 8 + wv]; S = a[i * 64 + lane] * S + k[i * 64 + lane] * vv; const float o = wave_sum(q[i * 64 + lane] * S); if (lane == i) oreg = o; }
        obuf[lane * 8 + wv] = oreg;
        if (n + 1 < 128) commit(b ^ 1);
        __syncthreads();
        if (tid < 64) { const int cn = dir ? 127 - n : n, row = cn * 64 + (dir ? 63 - tid : tid); float* op = og + (size_t)row * 512;
            *(f32x4*)op = *(const f32x4*)(obuf + tid * 8); *(f32x4*)(op + 4) = *(const f32x4*)(obuf + tid * 8 + 4); }
        __syncthreads();
    }
}

__device__ __forceinline__ void gdn_unit(Ctx& C, int unit) {
    const int sl = unit & 15, dir = (unit >> 4) & 1, h = (unit >> 5) & 3, sq = unit >> 7;
    const bf16* qkvc = (const bf16*)(C.ws + WS_QKVC) + (size_t)sq * SEQ * 1536; const float* gate = (const float*)(C.ws + WS_GATE) + (size_t)sq * SEQ * 16;
    float* og = (float*)(C.ws + WS_OGDN) + ((size_t)dir * HBR + (size_t)sq * SEQ) * 512 + h * 128 + sl * 8;
    float* obuf = (float*)C.lds;
    float* buf = obuf + 512;
    constexpr int BUFF = 2 * 8192 + 512 + 128;
    const int tid = C.tid, lane = C.lane, wv = C.wave;
    const int lr = tid >> 4, lc = (tid & 15) * 8;
    u32x4 rq0, rq1, rk0, rk1, rv; float rg = 0.f, rb = 0.f;
    auto issue = [&](int n) {
        const int cn = dir ? 127 - n : n; const int row0 = cn * 64 + (dir ? 63 - lr : lr), row1 = cn * 64 + (dir ? 63 - (lr + 32) : lr + 32);
        rq0 = *(const u32x4*)(qkvc + (size_t)row0 * 1536 + h * 128 + lc); rq1 = *(const u32x4*)(qkvc + (size_t)row1 * 1536 + h * 128 + lc);
        rk0 = *(const u32x4*)(qkvc + (size_t)row0 * 1536 + 512 + h * 128 + lc); rk1 = *(const u32x4*)(qkvc + (size_t)row1 * 1536 + 512 + h * 128 + lc);
        if (tid < 64) { const int row2 = cn * 64 + (dir ? 63 - tid : tid); rv = *(const u32x4*)(qkvc + (size_t)row2 * 1536 + 1024 + h * 128 + sl * 8);
            rg = gate[(size_t)row2 * 16 + dir * 8 + h]; rb = gate[(size_t)row2 * 16 + dir * 8 + 4 + h]; }
    };
    auto commit = [&](int b) {
        float* q = buf + b * BUFF; float* k = q + 8192; float* v = k + 8192; float* a = v + 512; float* be = a + 64;
        float x[8];
        unpack8(rq0, x);
#pragma unroll
        for (int i = 0; i < 8; ++i) q[lr * 128 + lc + i] = x[i];
        unpack8(rq1, x);
#pragma unroll
        for (int i = 0; i < 8; ++i) q[(lr + 32) * 128 + lc + i] = x[i];
        unpack8(rk0, x);
#pragma unroll
        for (int i = 0; i < 8; ++i) k[lr * 128 + lc + i] = x[i];
        unpack8(rk1, x);
#pragma unroll
        for (int i = 0; i < 8; ++i) k[(lr + 32) * 128 + lc + i] = x[i];
        if (tid < 64) { unpack8(rv, x);
#pragma unroll
            for (int i = 0; i < 8; ++i) v[tid * 8 + i] = x[i];
            a[tid] = __expf(rg); be[tid] = rb; }
    };
    float S0 = 0.f, S1 = 0.f;
    __syncthreads();
    issue(0); commit(0); __syncthreads();
    for (int n = 0; n < 128; ++n) {
        const int b = n & 1;
        if (n + 1 < 128) issue(n + 1);
        const float* q = buf + b * BUFF; const float* k = q + 8192; const float* v = k + 8192; const float* a = v + 512; const float* be = a + 64;
        float oreg = 0.f;
#pragma unroll 2
        for (int i = 0; i < 64; ++i) { const float at = a[i], bt = be[i], vv = v[i * 8 + wv], k0 = k[i * 128 + lane], k1 = k[i * 128 + 64 + lane];
            S0 *= at; S1 *= at; const float ks = wave_sum(k0 * S0 + k1 * S1); const float wvv = bt * (vv - ks); S0 += k0 * wvv; S1 += k1 * wvv;
            const float o = wave_sum(q[i * 128 + lane] * S0 + q[i * 128 + 64 + lane] * S1); if (lane == i) oreg = o; }
        obuf[lane * 8 + wv] = oreg;
        if (n + 1 < 128) commit(b ^ 1);
        __syncthreads();
        if (tid < 64) { const int cn = dir ? 127 - n : n, row = cn * 64 + (dir ? 63 - tid : tid); float* op = og + (size_t)row * 512;
            *(f32x4*)op = *(const f32x4*)(obuf + tid * 8); *(f32x4*)(op + 4) = *(const f32x4*)(obuf + tid * 8 + 4); }
        __syncthreads();
    }
}

namespace att {
using bf16x8 = __attribute__((ext_vector_type(8))) short;
using s16x4  = __attribute__((ext_vector_type(4))) short;
using f32x16 = __attribute__((ext_vector_type(16))) float;
constexpr int KVBLK = 64;
constexpr float SCALE = 0.125f, THR = 8.f;
constexpr int SHM_V = KVBLK * 128 * 2, SHM_K = KVBLK * 128 * 2;
#define KSWZ(row, colB) ((row) * 256 + ((colB) ^ (((row) & 7) << 4)))
#define SBAR() __builtin_amdgcn_sched_barrier(0)
__device__ __forceinline__ int crow(int r, int hi) { return (r & 3) + 8 * (r >> 2) + 4 * hi; }
__device__ __forceinline__ void partialSM(f32x16& p0, f32x16& p1, float& m_reg, float& mn, float& alpha) {
  constexpr float Cc = SCALE * 1.4426950408889634f;
  float pmax = p0[0]; for (int r = 1; r < 16; ++r) pmax = fmaxf(pmax, p0[r]); for (int r = 0; r < 16; ++r) pmax = fmaxf(pmax, p1[r]);
  { auto rr = __builtin_amdgcn_permlane32_swap(__float_as_uint(pmax), __float_as_uint(pmax), false, false);
    pmax = fmaxf(__uint_as_float(rr[0]), __uint_as_float(rr[1])); }
  if (__builtin_expect(__all(pmax - m_reg <= THR / SCALE), 1)) { mn = m_reg; alpha = 1.f; }
  else { mn = fmaxf(m_reg, pmax); alpha = __builtin_amdgcn_exp2f((m_reg - mn) * Cc); m_reg = mn; }
  float mnC = -mn * Cc;
  for (int r = 0; r < 16; ++r) p0[r] = fmaf(p0[r], Cc, mnC); for (int r = 0; r < 16; ++r) p1[r] = fmaf(p1[r], Cc, mnC);
  for (int r = 0; r < 16; ++r) p0[r] = __builtin_amdgcn_exp2f(p0[r]);
}
__device__ __forceinline__ void finishSM(f32x16& p0, f32x16& p1, float alpha, float& l_reg, bf16x8& pa0, bf16x8& pa1, bf16x8& pa2, bf16x8& pa3) {
  for (int r = 0; r < 16; ++r) p1[r] = __builtin_amdgcn_exp2f(p1[r]);
  float ps = 0; for (int r = 0; r < 16; ++r) ps += p0[r]; for (int r = 0; r < 16; ++r) ps += p1[r];
  { auto rr = __builtin_amdgcn_permlane32_swap(__float_as_uint(ps), __float_as_uint(ps), false, false);
    ps = __uint_as_float(rr[0]) + __uint_as_float(rr[1]); }
  l_reg = l_reg * alpha + ps;
#define PK4(P, BASE, OUT) do { unsigned a0 = cvtpk(P[BASE + 0], P[BASE + 1]), a1 = cvtpk(P[BASE + 2], P[BASE + 3]);   \
    unsigned b0 = cvtpk(P[BASE + 4], P[BASE + 5]), b1 = cvtpk(P[BASE + 6], P[BASE + 7]);                              \
    auto r0 = __builtin_amdgcn_permlane32_swap(a0, b0, false, false); auto r1 = __builtin_amdgcn_permlane32_swap(a1, b1, false, false); \
    u32x4 w = {r0[0], r1[0], r0[1], r1[1]}; OUT = *reinterpret_cast<bf16x8*>(&w); } while (0)
  PK4(p0, 0, pa0); PK4(p0, 8, pa1); PK4(p1, 0, pa2); PK4(p1, 8, pa3);
#undef PK4
}
__device__ __forceinline__ void qkt(f32x16& p0, f32x16& p1, const char* Ks, const bf16x8* qr, int r32, int hi, int s) {
  p0 = f32x16{}; p1 = f32x16{};
#pragma unroll
  for (int d0 = 0; d0 < 4; ++d0) { int cb = ((4 * s + d0) * 16 + hi * 8) * 2;
    bf16x8 b0 = *reinterpret_cast<const bf16x8*>(Ks + KSWZ(r32, cb));
    bf16x8 b1 = *reinterpret_cast<const bf16x8*>(Ks + KSWZ(32 + r32, cb));
    p0 = __builtin_amdgcn_mfma_f32_32x32x16_bf16(b0, qr[d0], p0, 0, 0, 0);
    p1 = __builtin_amdgcn_mfma_f32_32x32x16_bf16(b1, qr[d0], p1, 0, 0, 0); }
}
__device__ __forceinline__ int v_st(int k, int c) { const int kk = (k & ~0xC) | ((k & 4) << 1) | ((k & 8) >> 1); return ((kk >> 3) * 4 + (c >> 5)) * 512 + ((kk & 7) * 32 + (c & 31)) * 2; }
__device__ __forceinline__ int v_rd_base(int lane) { return ((lane & 3) << 3) | (((lane >> 2) & 3) << 6) | (((lane >> 4) & 1) << 5) | (((lane >> 5) & 1) << 8); }
constexpr int v_rd_off(int d0, int ks, int half) { return d0 * 512 + ks * 4096 + half * 2048; }
template <int OFF> __device__ __forceinline__ s16x4 tr_read(int vb) {
  s16x4 r; asm volatile("ds_read_b64_tr_b16 %0, %1 offset:%2" : "=&v"(r) : "v"(vb), "i"(OFF) : "memory"); return r;
}
template <int D0> __device__ __forceinline__ void pv_one(f32x16& od, int vb, bf16x8 pa0, bf16x8 pa1, bf16x8 pa2, bf16x8 pa3) {
  const s16x4 l0 = tr_read<v_rd_off(D0, 0, 0)>(vb), h0 = tr_read<v_rd_off(D0, 0, 1)>(vb), l1 = tr_read<v_rd_off(D0, 1, 0)>(vb), h1 = tr_read<v_rd_off(D0, 1, 1)>(vb);
  const s16x4 l2 = tr_read<v_rd_off(D0, 2, 0)>(vb), h2 = tr_read<v_rd_off(D0, 2, 1)>(vb), l3 = tr_read<v_rd_off(D0, 3, 0)>(vb), h3 = tr_read<v_rd_off(D0, 3, 1)>(vb);
  asm volatile("s_waitcnt lgkmcnt(0)" ::: "memory"); SBAR();
#define PK(Lo, Hi) (bf16x8){Lo[0], Lo[1], Lo[2], Lo[3], Hi[0], Hi[1], Hi[2], Hi[3]}
  od = __builtin_amdgcn_mfma_f32_32x32x16_bf16(pa0, PK(l0, h0), od, 0, 0, 0);
  od = __builtin_amdgcn_mfma_f32_32x32x16_bf16(pa1, PK(l1, h1), od, 0, 0, 0);
  od = __builtin_amdgcn_mfma_f32_32x32x16_bf16(pa2, PK(l2, h2), od, 0, 0, 0);
  od = __builtin_amdgcn_mfma_f32_32x32x16_bf16(pa3, PK(l3, h3), od, 0, 0, 0);
#undef PK
}
__device__ __forceinline__ void pv_d0(f32x16* o, int vb, bf16x8 pa0, bf16x8 pa1, bf16x8 pa2, bf16x8 pa3) {
  pv_one<0>(o[0], vb, pa0, pa1, pa2, pa3); pv_one<1>(o[1], vb, pa0, pa1, pa2, pa3); pv_one<2>(o[2], vb, pa0, pa1, pa2, pa3); pv_one<3>(o[3], vb, pa0, pa1, pa2, pa3);
}

__device__ __forceinline__ void attn_unit(const bf16* __restrict__ Qb, const bf16* __restrict__ Kh, const bf16* __restrict__ Vh, bf16* __restrict__ Yb,
                                          float lam, const float* gl, char* lds) {
  int tid_ = threadIdx.x; asm volatile("" : "+v"(tid_));
  const int tid = tid_, wid = __builtin_amdgcn_readfirstlane(tid >> 6), lane = tid & 63, r32 = lane & 31, hi = lane >> 5, s = wid >> 2, wq = wid & 3;
  char* V_lds = lds; char* K_lds = lds + 2 * SHM_V;
  float* ws = (float*)(lds + 2 * SHM_V + 2 * SHM_K) + wid * 64; float* li_l = ws; float* al_l = ws + 32;
  float m_reg = -1e30f, l_reg = 0; f32x16 o[4] = {}; bf16x8 qr[4];
  const bf16* Qw = Qb + (long)(wq * 32 + r32) * LDP + s * 64 + hi * 8;
#pragma unroll
  for (int d0 = 0; d0 < 4; ++d0) qr[d0] = *reinterpret_cast<const bf16x8*>(Qw + d0 * 16);
  const int sr = tid >> 4, sc = (tid & 15) * 8, vst0 = v_st(sr, sc), vst1 = v_st(32 + sr, sc);
  const int vb0 = (int)(uintptr_t)V_lds + v_rd_base(lane);
  struct { bf16x8 vs0, vs1, ks0, ks1; } sr_[2];
#define SLOAD(i, k0) do { sr_[i].vs0 = *reinterpret_cast<const bf16x8*>(&Vh[(long)((k0) + sr) * LDP + sc]); sr_[i].vs1 = *reinterpret_cast<const bf16x8*>(&Vh[(long)((k0) + 32 + sr) * LDP + sc]); \
    sr_[i].ks0 = *reinterpret_cast<const bf16x8*>(&Kh[(long)((k0) + sr) * LDP + sc]); sr_[i].ks1 = *reinterpret_cast<const bf16x8*>(&Kh[(long)((k0) + 32 + sr) * LDP + sc]); } while (0)
#define SWRITE(b, i) do { *(bf16x8*)(V_lds + (b) * SHM_V + vst0) = sr_[i].vs0;          \
    *(bf16x8*)(V_lds + (b) * SHM_V + vst1) = sr_[i].vs1; int kc = sc * 2;               \
    *(bf16x8*)(K_lds + (b) * SHM_K + KSWZ(sr, kc)) = sr_[i].ks0;                       \
    *(bf16x8*)(K_lds + (b) * SHM_K + KSWZ(32 + sr, kc)) = sr_[i].ks1; } while (0)
#define SWAIT() asm volatile("s_waitcnt vmcnt(4)" ::: "memory")
#define RESC(a) do { if (__any((a) < 1.f)) { if (hi == 0) al_l[r32] = (a); asm volatile("s_waitcnt lgkmcnt(0)" ::: "memory"); \
    for (int d = 0; d < 4; ++d) for (int r = 0; r < 16; ++r) o[d][r] *= al_l[crow(r, hi)]; } } while (0)
  f32x16 pA0, pA1, pB0, pB1; float mnA, mnB, alA, alB; bf16x8 pa0, pa1, pa2, pa3; const int NT = SEQ / KVBLK;
  constexpr int SE = 0, SO = 1;
  SLOAD(SE, 0); asm volatile("s_waitcnt vmcnt(0)" ::: "memory"); SWRITE(0, SE); __syncthreads();
  qkt(pA0, pA1, K_lds, qr, r32, hi, s); partialSM(pA0, pA1, m_reg, mnA, alA);
  SLOAD(SO, KVBLK); SLOAD(SE, 2 * KVBLK);
  SWAIT(); SWRITE(1, SO); __syncthreads();
  for (int j = 1; j + 1 < NT; j += 2) {
    SBAR(); qkt(pB0, pB1, K_lds + SHM_K, qr, r32, hi, s);
    finishSM(pA0, pA1, alA, l_reg, pa0, pa1, pa2, pa3); SBAR();
    SLOAD(SO, (j + 2) * KVBLK); SBAR();
    pv_d0(o, vb0, pa0, pa1, pa2, pa3); partialSM(pB0, pB1, m_reg, mnB, alB);
    __syncthreads(); SWAIT(); SWRITE(0, SE);
    RESC(alB); __syncthreads();
    SBAR(); qkt(pA0, pA1, K_lds, qr, r32, hi, s);
    finishSM(pB0, pB1, alB, l_reg, pa0, pa1, pa2, pa3); SBAR();
    if (j + 3 < NT) SLOAD(SE, (j + 3) * KVBLK); SBAR();
    pv_d0(o, vb0 + (int)SHM_V, pa0, pa1, pa2, pa3); partialSM(pA0, pA1, m_reg, mnA, alA);
    __syncthreads(); SWAIT(); SWRITE(1, SO);
    RESC(alA); __syncthreads();
  }
  SBAR(); qkt(pB0, pB1, K_lds + SHM_K, qr, r32, hi, s);
  finishSM(pA0, pA1, alA, l_reg, pa0, pa1, pa2, pa3); SBAR();
  pv_d0(o, vb0, pa0, pa1, pa2, pa3); partialSM(pB0, pB1, m_reg, mnB, alB);
  __syncthreads(); RESC(alB);
  finishSM(pB0, pB1, alB, l_reg, pa0, pa1, pa2, pa3); SBAR();
  pv_d0(o, vb0 + (int)SHM_V, pa0, pa1, pa2, pa3);
  if (hi == 0) li_l[r32] = l_reg; asm volatile("s_waitcnt lgkmcnt(0)" ::: "memory");
  float rli[16];
#pragma unroll
  for (int r = 0; r < 16; ++r) rli[r] = __builtin_amdgcn_rcpf(li_l[crow(r, hi)]);
  __syncthreads();
  int xb = (wq * 4096 + lane) * 4; asm volatile("" : "+v"(xb));
  float* X = (float*)(lds + xb);
  if (s == 1) {
#pragma unroll
    for (int d0 = 0; d0 < 4; ++d0)
#pragma unroll
      for (int r = 0; r < 16; ++r) X[(d0 * 16 + r) * 64] = o[d0][r] * rli[r];
  }
  __syncthreads();
  if (s == 0) {
    int yb = ((wq * 32 + 4 * hi) * 512 + r32) * 2; asm volatile("" : "+v"(yb));
    bf16* Yw = (bf16*)((char*)Yb + yb);
#pragma unroll
    for (int r = 0; r < 16; ++r) {
      float dv[4], t = 0.f;
#pragma unroll
      for (int d0 = 0; d0 < 4; ++d0) { dv[d0] = o[d0][r] * rli[r] - lam * X[(d0 * 16 + r) * 64]; t += dv[d0] * dv[d0]; }
      t += __shfl_xor(t, 1); t += __shfl_xor(t, 2); t += __shfl_xor(t, 4); t += __shfl_xor(t, 8); t += __shfl_xor(t, 16);
      const float rs = rsqrtf(t * (1.0f / 128.0f) + EPS);
#pragma unroll
      for (int d0 = 0; d0 < 4; ++d0) Yw[((r & 3) + 8 * (r >> 2)) * 512 + d0 * 32] = f2bf(dv[d0] * rs * gl[d0 * 32 + r32]);
    }
  }
  __syncthreads();
#undef SLOAD
#undef SWRITE
#undef SWAIT
#undef RESC
}
#undef KSWZ
#undef SBAR
}

__device__ __forceinline__ void phase_attention(Ctx& C, int l, int ubeg, int uend) {
  float* gl = (float*)(C.lds + 2 * att::SHM_V + 2 * att::SHM_K + NWAVES * 64 * 4);
  const float lam_init = 0.8f - 0.6f * __expf(-0.3f * (float)l);
  __syncthreads();
  if (C.tid < 128) gl[C.tid] = C.in[IN_DIFF_NORM][l * 128 + C.tid] * (1.0f - lam_init);
  if (C.tid == 128) { const float* lp = C.in[IN_DIFF_LAMBDA] + l * 256; float s1 = 0.f, s2 = 0.f;
    for (int i = 0; i < 64; ++i) { s1 += lp[i] * lp[64 + i]; s2 += lp[128 + i] * lp[192 + i]; }
    gl[128] = __expf(s1) - __expf(s2) + lam_init; }
  __syncthreads();
  const float lam = gl[128];
  const bf16* proj = (const bf16*)(C.ws + WS_PROJ); bf16* ys = (bf16*)(C.ws + WS_YS) + (size_t)HBR * 512;
  for (int u = ubeg + C.wg; u < uend; u += C.G) {
    const int qb = u & 63, h = (u >> 6) & 3, sq = u >> 8;
    const bf16* seqp = proj + (size_t)sq * SEQ * LDP;
    att::attn_unit(seqp + (size_t)(qb * 128) * LDP + C_DQ + 2 * h * 64, seqp + C_DK + h * 128, seqp + C_DV + h * 128,
                   ys + ((size_t)sq * SEQ + qb * 128) * 512 + h * 128, lam, gl, (char*)C.lds);
  }
}

__device__ __forceinline__ void phase_moe_prep(Ctx& C) {
    int* tot = (int*)(C.lds + 8 * 8704 + 4096); int* baseA = tot + 8; int* baseB = baseA + 8; int* off = baseB + 8;
    const int* gcnt = (const int*)(C.ws + WS_GCNT); const int* lpos = (const int*)(C.ws + WS_LPOS); const uint4* route = (const uint4*)(C.ws + WS_ROUTE);
    int* slotrow = (int*)(C.ws + WS_SLOTROW); int* tile_exp = (int*)(C.ws + WS_TILEEXP);
    const bf16* H = (const bf16*)(C.ws + WS_H); bf16* AS = (bf16*)(C.ws + WS_ASORT);
    __syncthreads();
    if (C.tid < 40) tot[C.tid] = 0;
    __syncthreads();
    { const int e = C.tid & 7, chunk = C.tid >> 3, gA = C.wg, gB = 256 + C.wg; int t = 0, a = 0, b = 0;
        for (int g = chunk * 8; g < chunk * 8 + 8; ++g) { const int c = gcnt[g * 8 + e]; t += c; if (g < gA) a += c; if (g < gB) b += c; }
        atomicAdd(&tot[e], t); atomicAdd(&baseA[e], a); atomicAdd(&baseB[e], b); }
    __syncthreads();
    if (C.tid == 0) { int o = 0; for (int e = 0; e < 8; ++e) { off[e] = o; o += (tot[e] + 255) & ~255; } off[8] = o; }
    __syncthreads();
    if (C.wg == 0 && C.tid < MOE_MAXT + 1) { if (C.tid == MOE_MAXT) tile_exp[MOE_MAXT] = off[8] >> 8;
        else { int e = 0; for (int q = 1; q < 8; ++q) if (C.tid * 256 >= off[q]) e = q; tile_exp[C.tid] = e; } }
    for (int hbi = 0; hbi < 2; ++hbi) { const int* base = hbi ? baseB : baseA;
        for (int i = C.wave; i < 64; i += NWAVES) { const int r = hbi * HBR + C.wg * 64 + i; const uint4 rt = route[r];
            const int row0 = off[rt.x] + base[rt.x] + lpos[2 * r], row1 = off[rt.y] + base[rt.y] + lpos[2 * r + 1];
            if (C.lane == 0) { slotrow[2 * r] = row0; slotrow[2 * r + 1] = row1; }
            const u32x4* src = (const u32x4*)(H + (size_t)r * DM) + C.lane; const u32x4 v0 = src[0], v1 = src[64];
            u32x4* d0 = (u32x4*)(AS + (size_t)row0 * DM) + C.lane; u32x4* d1 = (u32x4*)(AS + (size_t)row1 * DM) + C.lane;
            d0[0] = v0; d0[64] = v1; d1[0] = v0; d1[64] = v1; } }
    { const int gw = C.wg * NWAVES + C.wave;
        for (int e = 0; e < 8; ++e) { const int p0 = off[e] + tot[e], npad = off[e + 1] - p0;
            if (gw < npad) { u32x4* d = (u32x4*)(AS + (size_t)(p0 + gw) * DM) + C.lane; d[0] = (u32x4){0, 0, 0, 0}; d[64] = (u32x4){0, 0, 0, 0}; } } }
}

struct Args { const float* in[25]; float* out; unsigned char* ws; int ph_lo, ph_hi; };
constexpr int NPH = 45;

__global__ void __launch_bounds__(NTHREADS, 2) mk_fwd(Args args) {
    extern __shared__ __attribute__((aligned(16))) unsigned char lds[];
    Ctx C;
#pragma unroll
    for (int i = 0; i < 25; ++i) C.in[i] = args.in[i];
    C.out = args.out; C.ws = args.ws; C.lds = lds;
    C.tid = threadIdx.x; C.lane = C.tid & 63; C.wave = __builtin_amdgcn_readfirstlane(C.tid >> 6); C.wg = blockIdx.x; C.G = gridDim.x;
    LAS unsigned char* ldsl = (LAS unsigned char*)lds;
    volatile LAS unsigned* MISC = (volatile LAS unsigned*)(ldsl + MISC_OFF);
    if (C.tid < 64) MISC[C.tid] = 0u;
    __syncthreads();
    const int lo = args.ph_lo, hi = args.ph_hi;
    const bool multi = (hi - lo) > 1;
    XcdBarrier bar; bar.bar = (unsigned*)(C.ws + WS_CTL) + CW_BAR; bar.x = 0; bar.st = MISC + 8;
    if (multi) bar = xcd_barrier_post((unsigned*)(C.ws + WS_CTL) + CW_BAR, MISC + 8);
    int ph = 0;
#define ENTER() do { int t_ = threadIdx.x; asm volatile("" : "+v"(t_)); C.tid = t_; C.lane = t_ & 63; C.wave = __builtin_amdgcn_readfirstlane(t_ >> 6); } while (0)
#define RUN(k) ((k) >= lo && (k) < hi)
#ifndef PH_MASK
#define PH_MASK 0xFFFF
#endif
#define PHK(i) ((PH_MASK >> (i)) & 1)
#define SEAM(k) do { if (RUN(k) && RUN((k) + 1)) xcd_barrier(bar); } while (0)

    bf16* H = (bf16*)(C.ws + WS_H); bf16* PROJ = (bf16*)(C.ws + WS_PROJ);

    if (PHK(0) && RUN(ph)) { ENTER(); mod_partials(C); __syncthreads(); int base = 0; convert_mixer_weights(C, 0, base); convert_ffn_weights(C, base); }
    SEAM(ph); ++ph;
    if (PHK(1) && RUN(ph)) { ENTER(); phase_norm_in(C, C.in[IN_X], 0); }
    SEAM(ph); ++ph;

    for (int l_ = 0; l_ < 2; ++l_) {
        int l = l_; asm volatile("" : "+s"(l));
        for (int hb_ = 0; hb_ < 2; ++hb_) {
            int hb = hb_; asm volatile("" : "+s"(hb));
            if (PHK(2) && RUN(ph)) { ENTER(); pg8::Gemm g{H + (size_t)hb * HBR * DM, (const bf16*)(C.ws + WS_WIN), HBR, LDP, DM}; pg8::SchedPlain S; S.init(HBR, LDP, C.G, C.wg);
                pg8::EpiStoreBf16 E{PROJ, LDP, 0};
                pg8::gemm_phase<pg8::EpiStoreBf16, pg8::SchedPlain>(ldsl, g, S, E, nullptr); }
            SEAM(ph); ++ph;
            if (PHK(3) && RUN(ph)) { ENTER(); phase_postproj(C, hb, l); }
            SEAM(ph); ++ph;
            if (PHK(4) && RUN(ph)) { ENTER();
#ifndef CSUB
#define CSUB 7
#endif
                if (CSUB & 1) for (int u = C.wg; u < 256; u += C.G) gdn_unit(C, u);
                if (CSUB & 2) for (int u = C.wg; u < 256; u += C.G) gla_unit(C, u, l);
                if (CSUB & 4) phase_attention(C, l, 0, 512);
            }
            SEAM(ph); ++ph;
            if (PHK(5) && RUN(ph)) { ENTER(); phase_finalize(C, l); }
            SEAM(ph); ++ph;
            if (PHK(6) && RUN(ph)) { ENTER(); pg8::Gemm g{(const bf16*)(C.ws + WS_YS), (const bf16*)(C.ws + WS_WB), 3 * HBR, 3 * DM, 512}; pg8::SchedMerge S{HBR / 256, C.G, C.wg};
                pg8::EpiMerge E{PROJ + C_MG, LDP, (float*)(C.ws + WS_MERGEDF), (bf16*)(C.ws + WS_MERGED), HBR / 256};
                pg8::gemm_phase<pg8::EpiMerge, pg8::SchedMerge>(ldsl, g, S, E, nullptr); }
            SEAM(ph); ++ph;
            if (PHK(7) && RUN(ph)) { ENTER(); pg8::Gemm g{(const bf16*)(C.ws + WS_MERGED), (const bf16*)(C.ws + WS_WO), HBR, DM, DM}; pg8::SchedPlain S; S.init(HBR, DM, C.G, C.wg);
                pg8::EpiStoreF32 E{(float*)(C.ws + WS_Y), DM};
                pg8::gemm_phase<pg8::EpiStoreF32, pg8::SchedPlain>(ldsl, g, S, E, nullptr); }
            SEAM(ph); ++ph;
            if (PHK(8) && RUN(ph)) { ENTER(); phase_resnorm(C, hb * HBR, HBR, (l == 0) ? C.in[IN_X] : (const float*)C.out, (const float*)(C.ws + WS_Y), hb * HBR, false,
                                       l, 2, 1, true, l, 4, 3, 2, l == 1, hb * 256); }
            SEAM(ph); ++ph;
        }
        if (l == 0) {
            if (PHK(9) && RUN(ph)) { ENTER(); pg8::Gemm g{H, (const bf16*)(C.ws + WS_W13), TOK, 2 * DFF, DM}; pg8::SchedPlain S; S.init(TOK, 2 * DFF, C.G, C.wg);
                pg8::EpiSwiGLU E{(bf16*)(C.ws + WS_HID), DFF, 0, 0};
                pg8::gemm_phase<pg8::EpiSwiGLU, pg8::SchedPlain>(ldsl, g, S, E, nullptr); }
            SEAM(ph); ++ph;
            if (PHK(10) && RUN(ph)) { ENTER(); pg8::Gemm g{(const bf16*)(C.ws + WS_HID), (const bf16*)(C.ws + WS_W2), TOK, DM, DFF}; pg8::SchedPlain S; S.init(TOK, DM, C.G, C.wg);
                pg8::EpiStoreF32 E{(float*)(C.ws + WS_Y2), DM};
                pg8::gemm_phase<pg8::EpiStoreF32, pg8::SchedPlain>(ldsl, g, S, E, nullptr); }
            SEAM(ph); ++ph;
            if (PHK(11) && RUN(ph)) { ENTER(); phase_resnorm(C, 0, TOK, (const float*)C.out, (const float*)(C.ws + WS_Y2), 0, false, 0, 5, 3, true, 1, 1, 0, 0, false, 0);
                __syncthreads(); int base = 0; convert_mixer_weights(C, 1, base); }
            SEAM(ph); ++ph;
        } else {
            if (PHK(12) && RUN(ph)) { ENTER(); phase_moe_prep(C); __syncthreads(); int base = 0; convert_moe_weights(C, base); }
            SEAM(ph); ++ph;
            const int* tile_exp = (const int*)(C.ws + WS_TILEEXP);
            for (int p_ = 0; p_ < MOE_NPASS; ++p_) {
                int p = p_; asm volatile("" : "+s"(p));
                if (PHK(13) && RUN(ph)) { ENTER(); const int ntl = tile_exp[MOE_MAXT], t0 = p * MOE_PASS_T; int nt = ntl - t0; nt = nt < 0 ? 0 : (nt > MOE_PASS_T ? MOE_PASS_T : nt);
                    pg8::Gemm g{(const bf16*)(C.ws + WS_ASORT), (const bf16*)(C.ws + WS_MW13), 0, 0, DM}; pg8::SchedMoe1 S{tile_exp, t0, nt, C.G, C.wg};
                    pg8::EpiSwiGLU E{(bf16*)(C.ws + WS_MHID), DEXP, 1, t0};
                    pg8::gemm_phase<pg8::EpiSwiGLU, pg8::SchedMoe1>(ldsl, g, S, E, nullptr); }
                SEAM(ph); ++ph;
                if (PHK(14) && RUN(ph)) { ENTER(); const int ntl = tile_exp[MOE_MAXT], t0 = p * MOE_PASS_T; int nt = ntl - t0; nt = nt < 0 ? 0 : (nt > MOE_PASS_T ? MOE_PASS_T : nt);
                    pg8::Gemm g{(const bf16*)(C.ws + WS_MHID), (const bf16*)(C.ws + WS_MW2), 0, 0, DEXP}; pg8::SchedMoe2 S{tile_exp, t0, nt, C.G, C.wg};
                    pg8::EpiStoreBf16 E{(bf16*)(C.ws + WS_ASORT), DM, 1};
                    pg8::gemm_phase<pg8::EpiStoreBf16, pg8::SchedMoe2>(ldsl, g, S, E, nullptr); }
                SEAM(ph); ++ph;
            }
            if (PHK(15) && RUN(ph)) { ENTER(); phase_resnorm(C, 0, TOK, (const float*)C.out, nullptr, 0, true, 1, 5, 3, false, 1, 0, 0, 0, false, 0); }
            ++ph;
        }
    }
#undef RUN
#undef SEAM
}

extern "C" void kernel_launch(void* const* d_in, const int* in_sizes, int n_in, void* d_out, int out_size, void* d_ws, size_t ws_size, hipStream_t stream) {
    static int grid = 0;
    if (grid == 0) {
        if (n_in != 25 || out_size != TOK * DM || ws_size < WS_END) { fprintf(stderr, "kernel_launch: unexpected problem (n_in %d out %d ws %zu, need ws >= %zu)\n", n_in, out_size, ws_size, (size_t)WS_END); grid = -1; return; }
        int dev = 0, cus = 0, per_cu = 0;
        if (hipGetDevice(&dev) != hipSuccess || hipDeviceGetAttribute(&cus, hipDeviceAttributeMultiprocessorCount, dev) != hipSuccess) { grid = -1; return; }
        if (hipFuncSetAttribute((const void*)mk_fwd, hipFuncAttributeMaxDynamicSharedMemorySize, LDS_BYTES) != hipSuccess) { fprintf(stderr, "kernel_launch: hipFuncSetAttribute failed\n"); grid = -1; return; }
        if (hipOccupancyMaxActiveBlocksPerMultiprocessor(&per_cu, (const void*)mk_fwd, NTHREADS, LDS_BYTES) != hipSuccess || per_cu < 1) fprintf(stderr, "kernel_launch: occupancy query says %d\n", per_cu);
        (void)hipGetLastError();
        grid = cus;
        if (grid != 256) fprintf(stderr, "kernel_launch: %d CUs (built for 256)\n", grid);
    }
    if (grid < 0) return;
    (void)hipMemsetAsync((char*)d_ws + WS_CTL, 0, CTL_ZERO_BYTES, stream);
    Args a{};
    for (int i = 0; i < 25; ++i) a.in[i] = (const float*)d_in[i];
    a.out = (float*)d_out; a.ws = (unsigned char*)d_ws;
#if MK_ONE_LAUNCH
    a.ph_lo = 0; a.ph_hi = NPH;
    hipLaunchKernelGGL(mk_fwd, dim3(grid), dim3(NTHREADS), LDS_BYTES, stream, a);
#else
    for (int p = 0; p < NPH; ++p) { a.ph_lo = p; a.ph_hi = p + 1; hipLaunchKernelGGL(mk_fwd, dim3(grid), dim3(NTHREADS), LDS_BYTES, stream, a); }
#endif
    const hipError_t le = hipPeekAtLastError();
    if (le != hipSuccess) fprintf(stderr, "kernel_launch: launch failed: %s\n", hipGetErrorName(le));
}
```

```cpp
#include <hip/hip_runtime.h>
#include <cstdio>
#include <cstdint>

#ifndef MK_ONE_LAUNCH
#define MK_ONE_LAUNCH 1
#endif

constexpr int DM = 1024, NBATCH = 4, SEQ = 8192, TOK = NBATCH * SEQ, HBR = 16384;
constexpr int INC = 8240, LDP = 8448;
constexpr int C_GQ = 0, C_GK = 256, C_GV = 512, C_GR = 1024, C_GWF = 1536, C_GWB = 1552, C_DQ = 1568, C_DK = 2080, C_DV = 2592,
              C_NQ = 3104, C_NK = 3616, C_NV = 4128, C_NZ = 4640, C_NBF = 5152, C_NBB = 5156, C_NAF = 5160, C_NAB = 5164, C_MG = 5168;
constexpr int DFF = 2816, NEXP = 8, DEXP = 3584;
constexpr float EPS = 1e-6f;
constexpr int NTHREADS = 512, NWAVES = 8;
constexpr int MOE_MAXT = 264, MOE_PASS_T = 128, MOE_NPASS = 3;

constexpr size_t MiB = 1u << 20;
constexpr size_t WS_CTL = 0, CTL_ZERO_BYTES = 1 * MiB;
constexpr size_t WS_MODP = 1 * MiB;
constexpr size_t WS_MODF = 2 * MiB + 512 * 1024;
constexpr size_t WS_ROUTE = 3 * MiB;
constexpr size_t WS_LPOS = 3 * MiB + 512 * 1024;
constexpr size_t WS_SLOTROW = 3 * MiB + 768 * 1024;
constexpr size_t WS_GCNT = 4 * MiB;
constexpr size_t WS_TILEEXP = 4 * MiB + 64 * 1024;
constexpr size_t WS_GATE = 5 * MiB;
constexpr size_t WS_GB = 5 * MiB;
constexpr size_t WS_WIN = 8 * MiB;
constexpr size_t WS_WB = WS_WIN + (size_t)LDP * DM * 2;
constexpr size_t WS_WO = WS_WB + 3u * 1024 * 512 * 2;
constexpr size_t WS_H = 32 * MiB;
constexpr size_t WS_PROJ = 96 * MiB;
constexpr size_t WS_QKVC = 360 * MiB;
constexpr size_t WS_QN = 360 * MiB;
constexpr size_t WS_GAM = 376 * MiB;
constexpr size_t WS_GKET = 392 * MiB;
constexpr size_t WS_GDEC = 5 * MiB + 512 * 1024;
constexpr size_t WS_OGLA = 408 * MiB;
constexpr size_t WS_OGDN = 440 * MiB;
constexpr size_t WS_U = 472 * MiB;
constexpr size_t WS_W = 504 * MiB;
constexpr size_t WS_YS = 536 * MiB;
constexpr size_t WS_ATT = WS_YS;
constexpr size_t WS_KT = WS_YS + 32 * MiB;
constexpr size_t WS_W13 = 584 * MiB;
constexpr size_t WS_W2 = WS_W13 + (size_t)2 * DFF * DM * 2;
constexpr size_t WS_MERGEDF = 360 * MiB;
constexpr size_t WS_MERGED = 424 * MiB;
constexpr size_t WS_Y = 472 * MiB;
constexpr size_t WS_HID = 96 * MiB;
constexpr size_t WS_Y2 = 272 * MiB;
constexpr size_t WS_MW13 = 96 * MiB;
constexpr size_t WS_MW2 = 208 * MiB;
constexpr size_t WS_ASORT = 264 * MiB;
constexpr size_t WS_MHID = 396 * MiB;
constexpr size_t WS_MPART = WS_H;
constexpr size_t WS_END = 620 * MiB;
static_assert(WS_W2 + (size_t)DM * DFF * 2 <= WS_END && WS_WO + 2u * MiB <= WS_H && WS_HID + (size_t)TOK * DFF * 2 <= WS_Y2 && WS_MHID + 224 * MiB <= WS_END, "ws map");
constexpr int CW_BAR = 4096;

constexpr int RING_BYTES = 131072;
constexpr int LDS_BYTES = 147456;
constexpr int MISC_OFF = LDS_BYTES - 256;

#define LAS __attribute__((address_space(3)))
typedef unsigned short bf16;
typedef float f32x4 __attribute__((ext_vector_type(4)));
typedef unsigned u32x4 __attribute__((ext_vector_type(4)));
typedef unsigned u32x2 __attribute__((ext_vector_type(2)));

typedef __bf16 bf16x2_t __attribute__((ext_vector_type(2)));
typedef float f32x2_t __attribute__((ext_vector_type(2)));
__device__ __forceinline__ unsigned cvtpk(float lo, float hi) { const f32x2_t v = {lo, hi}; const bf16x2_t b = __builtin_convertvector(v, bf16x2_t); return __builtin_bit_cast(unsigned, b); }
struct WT { __amdgpu_buffer_rsrc_t rs; const unsigned char* base; };
__device__ __forceinline__ WT wt_make(unsigned char* ws) { WT w; w.rs = __builtin_amdgcn_make_buffer_rsrc(ws, 0, 0x7FFFFFFF, 0x00020000); w.base = ws; return w; }
__device__ __forceinline__ void wt16(const WT& w, const void* p, u32x4 v) { __builtin_amdgcn_raw_buffer_store_b128(v, w.rs, (int)((const unsigned char*)p - w.base), 0, 16); }
__device__ __forceinline__ void wt8(const WT& w, const void* p, u32x2 v) { __builtin_amdgcn_raw_buffer_store_b64(v, w.rs, (int)((const unsigned char*)p - w.base), 0, 16); }
__device__ __forceinline__ void wt4(const WT& w, const void* p, unsigned v) { __builtin_amdgcn_raw_buffer_store_b32(v, w.rs, (int)((const unsigned char*)p - w.base), 0, 16); }
__device__ __forceinline__ void wt2(const WT& w, const void* p, unsigned short v) { __builtin_amdgcn_raw_buffer_store_b16(v, w.rs, (int)((const unsigned char*)p - w.base), 0, 16); }
__device__ __forceinline__ float bflo(unsigned w) { return __uint_as_float(w << 16); }
__device__ __forceinline__ float bfhi(unsigned w) { return __uint_as_float(w & 0xffff0000u); }
__device__ __forceinline__ float bf2f(bf16 b) { return __uint_as_float(((unsigned)b) << 16); }
__device__ __forceinline__ bf16 f2bf(float f) { return (bf16)(cvtpk(f, 0.f) & 0xffffu); }
__device__ __forceinline__ void unpack8(const u32x4 w, float* x) { x[0] = bflo(w.x); x[1] = bfhi(w.x); x[2] = bflo(w.y); x[3] = bfhi(w.y); x[4] = bflo(w.z); x[5] = bfhi(w.z); x[6] = bflo(w.w); x[7] = bfhi(w.w); }
__device__ __forceinline__ u32x4 pack8(const float* x) { u32x4 w; w.x = cvtpk(x[0], x[1]); w.y = cvtpk(x[2], x[3]); w.z = cvtpk(x[4], x[5]); w.w = cvtpk(x[6], x[7]); return w; }
__device__ __forceinline__ float sigmoidf_(float x) { return __builtin_amdgcn_rcpf(1.0f + __expf(-x)); }
__device__ __forceinline__ float siluf_(float x) { return x * __builtin_amdgcn_rcpf(1.0f + __expf(-x)); }
#define DPP_ADD(v, ctrl) ((v) + __builtin_bit_cast(float, __builtin_amdgcn_update_dpp(0, __builtin_bit_cast(int, (v)), (ctrl), 0xF, 0xF, true)))
__device__ __forceinline__ float grp8_sum(float v) { v = DPP_ADD(v, 0xB1); v = DPP_ADD(v, 0x4E); v = DPP_ADD(v, 0x141); return v; }
__device__ __forceinline__ float grp16_sum(float v) { v = grp8_sum(v); v = DPP_ADD(v, 0x140); return v; }
__device__ __forceinline__ float grp32_sum(float v) { v = grp16_sum(v); v += __shfl_xor(v, 16); return v; }
__device__ __forceinline__ float wave_sum(float v) { v = grp32_sum(v);
    auto rr = __builtin_amdgcn_permlane32_swap(__float_as_uint(v), __float_as_uint(v), false, false); return __uint_as_float(rr[0]) + __uint_as_float(rr[1]); }

namespace pg8 {
#define PG8_LAS __attribute__((address_space(3)))
typedef unsigned short bf16_t;
typedef short bf16x8 __attribute__((ext_vector_type(8)));
typedef float f32x4 __attribute__((ext_vector_type(4)));
typedef unsigned u32x4 __attribute__((ext_vector_type(4)));
constexpr int BM = 256, BK = 64, HALF = 128, HTB = HALF * BK * 2  , STAGE_BYTES = 8 * HTB, NXCD = 8, WGM = 8;

__host__ __device__ __forceinline__ int lds_byte(int r, int c) { const int st = (r >> 4) * 2 + (c >> 5), rr = r & 15, cc = c & 31, ob = rr * 64 + cc * 2; return st * 1024 + (ob ^ (((ob >> 9) & 1) << 5)); }
__host__ __device__ __forceinline__ void stage_rc(int b, int& R, int& C) { const int st = b / 1024, sb = b % 1024, swz = sb ^ (((sb >> 9) & 1) << 5); R = (st >> 1) * 16 + swz / 64; C = (st & 1) * 32 + (swz % 64) / 2; }
__host__ __device__ __forceinline__ int perm32(int rho) { const int n = rho >> 4, i = rho & 15; return 8 * (i >> 2) + 4 * n + (i & 3); }

struct Unit { int pm, pn, aux, koff; };
struct Gemm { const bf16_t* A; const bf16_t* Bt; int M, N, K, ldk; };

struct StaticOrder {
    int nM, nN, nwg, G, c;
    __host__ __device__ void init(int M, int N, int G_, int c_) { nM = M / BM; nN = N / BM; nwg = nM * nN; G = G_; c = c_; }
    __host__ __device__ bool next(int i, Unit& u) const {
        const long L = (long)i * G + c; if (L >= nwg) return false;
        int wgid = (int)L; { const int q = nwg / NXCD, r = nwg % NXCD, xcd = wgid % NXCD, off = wgid / NXCD; wgid = (xcd < r ? xcd * (q + 1) : r * (q + 1) + (xcd - r) * q) + off; }
        const int nig = WGM * nN, gid = wgid / nig, fm = gid * WGM, gsz = (nM - fm) < WGM ? (nM - fm) : WGM;
        u.pm = fm + ((wgid % nig) % gsz); u.pn = (wgid % nig) / gsz; u.aux = 0; u.koff = 0; return true;
    }
    __device__ __forceinline__ void a_ready(const Unit&) const {}
    __device__ __forceinline__ void done(const Unit&) const {}
};
struct CountedOrder : StaticOrder {
    const unsigned* ready; unsigned need; unsigned* tmo;
    __device__ __forceinline__ void a_ready(const Unit& u) const {
        if (threadIdx.x < 64) {
            const unsigned long long t0 = __builtin_amdgcn_s_memrealtime(); unsigned polls = 0;
            while ((unsigned)__builtin_amdgcn_readfirstlane(__hip_atomic_load(ready + 64 * u.pm, __ATOMIC_RELAXED, __HIP_MEMORY_SCOPE_AGENT)) < need) {
                if ((++polls & 255u) == 0u && __builtin_amdgcn_readfirstlane(__hip_atomic_load(tmo, __ATOMIC_RELAXED, __HIP_MEMORY_SCOPE_AGENT)) != 0u) break;
                if (__builtin_amdgcn_s_memrealtime() - t0 > 2000000ull) {
                    if (threadIdx.x == 0) { unsigned expect = 0u; __hip_atomic_compare_exchange_strong(tmo + 1, &expect, 0x600u | (unsigned)(u.pm & 0xff), __ATOMIC_RELAXED, __ATOMIC_RELAXED, __HIP_MEMORY_SCOPE_AGENT); __hip_atomic_store(tmo, 1u, __ATOMIC_RELAXED, __HIP_MEMORY_SCOPE_AGENT); }
                    break; }
                __builtin_amdgcn_s_sleep(2); }
            __builtin_amdgcn_fence(__ATOMIC_ACQUIRE, "agent");
            asm volatile("s_waitcnt vmcnt(0)" ::: "memory");
        }
#if !defined(BROKEN_HOOK_NO_BARRIER)
        asm volatile("" ::: "memory"); __builtin_amdgcn_s_barrier(); asm volatile("" ::: "memory");
#endif
    }
};

__device__ __forceinline__ unsigned cvt_pk_bf16(float lo, float hi) { return ::cvtpk(lo, hi); }
typedef float f32x2 __attribute__((ext_vector_type(2)));
__device__ __forceinline__ f32x2 gelu_pk(f32x2 v) {
    const f32x2 av = __builtin_elementwise_abs(v), d = av * 0.2316418882f + 1.0f;
    f32x2 t; t.x = __builtin_amdgcn_rcpf(d.x); t.y = __builtin_amdgcn_rcpf(d.y);
    f32x2 q = t * 0.5307027145f + (-0.7265760135f); q = q * t + 0.7107068705f; q = q * t + (-0.142248368f); q = q * t + 0.127414796f; q = q * t;
    const f32x2 s = (v * v) * (-0.72134752044f);
    f32x2 e; e.x = __builtin_amdgcn_exp2f(s.x); e.y = __builtin_amdgcn_exp2f(s.y);
    const f32x2 m = v * (q * e), r = v - m;
    f32x2 o; o.x = v.x < 0.f ? m.x : r.x; o.y = v.y < 0.f ? m.y : r.y; return o;
}

struct EpiF32 {
    static constexpr bool PERM = false, AFTER_DRAIN = false;
    float* C; int ldc; const float* bias;
    __device__ __forceinline__ void operator()(const f32x4 (&acc)[2][2][4][2], const Unit& u, int wr, int wc, int fr, int fq) const {
        const int row0 = u.pm * BM + wr * 64 + fr, col0 = u.pn * BM + wc * 32 + 4 * fq;
        f32x4 bv[2][2];
#pragma unroll
        for (int bj = 0; bj < 2; ++bj)
#pragma unroll
            for (int n = 0; n < 2; ++n) bv[bj][n] = bias ? *(const f32x4*)(bias + col0 + bj * HALF + n * 16) : (f32x4){0.f, 0.f, 0.f, 0.f};
#pragma unroll
        for (int ai = 0; ai < 2; ++ai)
#pragma unroll
            for (int m = 0; m < 4; ++m) { float* rowp = C + (size_t)(row0 + ai * HALF + m * 16) * ldc + col0;
#pragma unroll
                for (int bj = 0; bj < 2; ++bj)
#pragma unroll
                    for (int n = 0; n < 2; ++n) *(f32x4*)(rowp + bj * HALF + n * 16) = acc[ai][bj][m][n] + bv[bj][n]; }
    }
};
template <int ACT  > struct EpiBf16 {
    static constexpr bool PERM = true, AFTER_DRAIN = false;
    bf16_t* O; int ldc; const float* bias; int split_cols; size_t split_stride;
    __device__ __forceinline__ void operator()(const f32x4 (&acc)[2][2][4][2], const Unit& u, int wr, int wc, int fr, int fq) const {
        const int row0 = u.pm * BM + wr * 64 + fr; int colt = u.pn * BM; bf16_t* base = O;
        if (split_cols) { const int t = colt / split_cols; base += (size_t)t * split_stride; colt -= t * split_cols; }
        const int col0 = colt + wc * 32 + 8 * fq, bcol0 = u.pn * BM + wc * 32 + 8 * fq;
        f32x4 bv[2][2];
#pragma unroll
        for (int bj = 0; bj < 2; ++bj)
#pragma unroll
            for (int n = 0; n < 2; ++n) bv[bj][n] = bias ? *(const f32x4*)(bias + bcol0 + bj * HALF + 4 * n) : (f32x4){0.f, 0.f, 0.f, 0.f};
#pragma unroll
        for (int ai = 0; ai < 2; ++ai)
#pragma unroll
            for (int m = 0; m < 4; ++m) { bf16_t* rowp = base + (size_t)(row0 + ai * HALF + m * 16) * ldc + col0;
#pragma unroll
                for (int bj = 0; bj < 2; ++bj) { f32x4 v0 = acc[ai][bj][m][0] + bv[bj][0], v1 = acc[ai][bj][m][1] + bv[bj][1];
                    if (ACT == 1) { f32x2 a = gelu_pk((f32x2){v0[0], v0[1]}), b = gelu_pk((f32x2){v0[2], v0[3]}), c = gelu_pk((f32x2){v1[0], v1[1]}), d = gelu_pk((f32x2){v1[2], v1[3]});
                        v0 = (f32x4){a.x, a.y, b.x, b.y}; v1 = (f32x4){c.x, c.y, d.x, d.y}; }
                    if (ACT == 2) {
#pragma unroll
                        for (int j = 0; j < 4; ++j) { v0[j] = 0.5f * v0[j] * (1.0f + erff(v0[j] * 0.70710678f)); v1[j] = 0.5f * v1[j] * (1.0f + erff(v1[j] * 0.70710678f)); } }
                    u32x4 w; w.x = cvt_pk_bf16(v0[0], v0[1]); w.y = cvt_pk_bf16(v0[2], v0[3]); w.z = cvt_pk_bf16(v1[0], v1[1]); w.w = cvt_pk_bf16(v1[2], v1[3]);
                    *(u32x4*)(rowp + bj * HALF) = w; } }
    }
};
template <class Epi, class Sched, bool STAMP = false>
__device__ __forceinline__ void gemm_phase(PG8_LAS unsigned char* lds, const Gemm g, const Sched& S, const Epi& E, unsigned long long* stamps) {
    int tid_ = threadIdx.x; asm volatile("" : "+v"(tid_));
    const int tid = tid_, wid = __builtin_amdgcn_readfirstlane(tid >> 6), lane = tid & 63, wr = wid >> 2, wc = wid & 3, fr = lane & 15, fq = lane >> 4;
    const int K = g.K, nt = K / BK, LDK = g.ldk ? g.ldk : g.K;
    int ts_lo = 0, ts_hi = 0, nts = 0; const unsigned long long rt_entry = STAMP ? (unsigned long long)wall_clock64() : 0ull;
#define PG8_STAMP() do { if (STAMP && wid == 0 && nts < 64) { const unsigned long long _c = (unsigned long long)clock64(); \
        ts_lo = (lane == nts) ? (int)(unsigned)_c : ts_lo; ts_hi = (lane == nts) ? (int)(unsigned)(_c >> 32) : ts_hi; ++nts; } } while (0)
    PG8_STAMP();
    unsigned voffA[2], voffB[2];
#pragma unroll
    for (int i = 0; i < 2; ++i) { int R, C; stage_rc(tid * 16 + i * 8192, R, C); const int Rb = Epi::PERM ? ((R & ~31) + perm32(R & 31)) : R;
        voffA[i] = (unsigned)(R * LDK + C) * 2u; voffB[i] = (unsigned)(Rb * LDK + C) * 2u; }
    const size_t kstep = (size_t)(BK * 2);
    const size_t hstep = (size_t)HALF * LDK * 2;
    const size_t tstep = 2 * hstep;
    const unsigned ldsw = (unsigned)wid * 1024u;
    const int aoff = lds_byte(wr * 64 + fr, fq * 8), boff = lds_byte(wc * 32 + fr, fq * 8);
#define PG8_SA(b, h) (((b) * 2 + (h)) * HTB)
#define PG8_SB(b, h) ((4 + (b) * 2 + (h)) * HTB)
#define PG8_STAGE(bufoff, gbase, voff) do { _Pragma("unroll") for (int _i = 0; _i < 2; ++_i) \
        __builtin_amdgcn_global_load_lds((const unsigned*)((const char*)(gbase) + (voff)[_i]), (PG8_LAS unsigned*)(lds + (bufoff) + ldsw + _i * 8192), 16, 0, 0); } while (0)
#define PG8_LDA(dst, b, h) do { _Pragma("unroll") for (int m = 0; m < 4; ++m) _Pragma("unroll") for (int k = 0; k < 2; ++k) dst[m][k] = *(const PG8_LAS bf16x8*)(lds + PG8_SA(b, h) + aoff + m * 2048 + k * 1024); } while (0)
#define PG8_LDB(dst, b, h) do { _Pragma("unroll") for (int n = 0; n < 2; ++n) _Pragma("unroll") for (int k = 0; k < 2; ++k) dst[n][k] = *(const PG8_LAS bf16x8*)(lds + PG8_SB(b, h) + boff + n * 2048 + k * 1024); } while (0)
#define PG8_MMA(ai, bj, At, Bt) do { __builtin_amdgcn_s_setprio(1); _Pragma("unroll") for (int m = 0; m < 4; ++m) _Pragma("unroll") for (int n = 0; n < 2; ++n) _Pragma("unroll") for (int k = 0; k < 2; ++k) \
        acc[ai][bj][m][n] = __builtin_amdgcn_mfma_f32_16x16x32_bf16(Bt[n][k], At[m][k], acc[ai][bj][m][n], 0, 0, 0); __builtin_amdgcn_s_setprio(0); } while (0)
#define PG8_WAIT_V(n) asm volatile("s_waitcnt vmcnt(" #n ")" ::: "memory")
#define PG8_WAIT_L(n) asm volatile("s_waitcnt lgkmcnt(" #n ")" ::: "memory")
#define PG8_BAR __builtin_amdgcn_s_barrier()
#define PG8_SCHED __builtin_amdgcn_sched_barrier(0)
    Unit cur, nxt; int ui = 0;
    if (!S.next(0, cur)) return;
    f32x4 acc[2][2][4][2];
#pragma unroll
    for (int a = 0; a < 2; ++a)
#pragma unroll
        for (int b = 0; b < 2; ++b)
#pragma unroll
            for (int m = 0; m < 4; ++m)
#pragma unroll
                for (int n = 0; n < 2; ++n) acc[a][b][m][n] = (f32x4){0.f, 0.f, 0.f, 0.f};
    bf16x8 At[4][2], B0[2][2], B1[2][2];
    const char* cA = (const char*)g.A + (size_t)cur.pm * tstep + (size_t)cur.koff * 2; const char* cB = (const char*)g.Bt + (size_t)cur.pn * tstep + (size_t)cur.koff * 2;
    S.a_ready(cur);
    PG8_STAGE(PG8_SB(0, 0), cB, voffB); PG8_STAGE(PG8_SA(0, 0), cA, voffA); PG8_STAGE(PG8_SB(0, 1), cB + hstep, voffB); PG8_STAGE(PG8_SA(0, 1), cA + hstep, voffA);
    if (wr == 1) PG8_BAR;
    PG8_WAIT_V(4); PG8_BAR;
    PG8_STAGE(PG8_SB(1, 0), cB + kstep, voffB); PG8_STAGE(PG8_SA(1, 0), cA + kstep, voffA); PG8_STAGE(PG8_SB(1, 1), cB + hstep + kstep, voffB);
    PG8_WAIT_V(6); PG8_BAR;
    PG8_STAMP();
    for (;;) {
        const bool has_next = S.next(ui + 1, nxt);
        const char* nA = has_next ? (const char*)g.A + (size_t)nxt.pm * tstep + (size_t)nxt.koff * 2 : cA; const char* nB = has_next ? (const char*)g.Bt + (size_t)nxt.pn * tstep + (size_t)nxt.koff * 2 : cB;
        for (int t = 0; t < nt; t += 2) {
            const bool last = (t == nt - 2);
            const char* a1 = cA + (size_t)(t + 1) * kstep;
            const char* a2 = last ? nA : cA + (size_t)(t + 2) * kstep; const char* b2 = last ? nB : cB + (size_t)(t + 2) * kstep;
            const char* a3 = a2 + kstep; const char* b3 = b2 + kstep;
            if (last && has_next) S.a_ready(nxt);
            PG8_LDB(B0, 0, 0); PG8_SCHED; PG8_LDA(At, 0, 0); PG8_STAGE(PG8_SA(1, 1), a1 + hstep, voffA);
            PG8_WAIT_L(8); PG8_BAR; PG8_WAIT_L(0); PG8_MMA(0, 0, At, B0); PG8_BAR; PG8_SCHED;
            PG8_LDB(B1, 0, 1); PG8_STAGE(PG8_SB(0, 0), b2, voffB);
            PG8_BAR; PG8_WAIT_L(0); PG8_MMA(0, 1, At, B1); PG8_BAR;
            PG8_LDA(At, 0, 1); PG8_STAGE(PG8_SA(0, 0), a2, voffA);
            PG8_BAR; PG8_WAIT_L(0); PG8_MMA(1, 0, At, B0); PG8_BAR; PG8_SCHED;
            PG8_STAGE(PG8_SB(0, 1), b2 + hstep, voffB);
            PG8_WAIT_V(6); PG8_BAR; PG8_MMA(1, 1, At, B1); PG8_BAR;
            PG8_LDB(B0, 1, 0); PG8_SCHED; PG8_LDA(At, 1, 0); PG8_STAGE(PG8_SA(0, 1), a2 + hstep, voffA);
            PG8_WAIT_L(8); PG8_BAR; PG8_WAIT_L(0); PG8_MMA(0, 0, At, B0); PG8_BAR; PG8_SCHED;
            PG8_LDB(B1, 1, 1); PG8_STAGE(PG8_SB(1, 0), b3, voffB);
            PG8_BAR; PG8_WAIT_L(0); PG8_MMA(0, 1, At, B1); PG8_BAR;
            PG8_LDA(At, 1, 1); PG8_STAGE(PG8_SA(1, 0), a3, voffA);
            PG8_BAR; PG8_WAIT_L(0); PG8_MMA(1, 0, At, B0); PG8_BAR; PG8_SCHED;
            PG8_STAGE(PG8_SB(1, 1), b3 + hstep, voffB);
            PG8_WAIT_V(6); PG8_BAR; PG8_MMA(1, 1, At, B1); PG8_BAR;
        }
        PG8_STAMP();
        bool keep = false;
        if constexpr (!Epi::AFTER_DRAIN) { if constexpr (Epi::INPLACE) keep = E.inplace(acc, cur, wr, wc, fr, fq); else E(acc, cur, wr, wc, fr, fq); S.done(cur); }
        PG8_STAMP();
        if (!has_next) break;
        if (!keep) {
#pragma unroll
        for (int a = 0; a < 2; ++a)
#pragma unroll
            for (int b = 0; b < 2; ++b)
#pragma unroll
                for (int m = 0; m < 4; ++m)
#pragma unroll
                    for (int n = 0; n < 2; ++n) acc[a][b][m][n] = (f32x4){0.f, 0.f, 0.f, 0.f};
        }
        cur = nxt; cA = nA; cB = nB; ++ui;
    }
    PG8_WAIT_V(0);
    if (wr == 0) PG8_BAR;
    PG8_BAR;
    if constexpr (Epi::AFTER_DRAIN) { E.fused(acc, cur, wr, wc, fr, fq, lds, wid, lane); S.done(cur); }
    PG8_STAMP();
    if (STAMP && wid == 0) { stamps[lane] = lane < nts ? (((unsigned long long)(unsigned)ts_hi << 32) | (unsigned)ts_lo) : 0ull;
        if (lane == 62) stamps[62] = rt_entry; if (lane == 63) stamps[63] = (unsigned long long)wall_clock64(); }
#undef PG8_STAMP
#undef PG8_SA
#undef PG8_SB
#undef PG8_STAGE
#undef PG8_LDA
#undef PG8_LDB
#undef PG8_MMA
#undef PG8_WAIT_V
#undef PG8_WAIT_L
#undef PG8_BAR
#undef PG8_SCHED
}
}

namespace pg8 {
struct SchedPlain {
    int nM, nN, G, c;
    __device__ void init(int M, int N, int G_, int c_) { nM = M / BM; nN = N / BM; G = G_; c = c_; }
    __device__ bool next(int i, Unit& u) const { const int L = i * G + c; if (L >= nM * nN) return false; u.pm = L % nM; u.pn = L / nM; u.aux = 0; u.koff = 0; return true; }
    __device__ __forceinline__ void a_ready(const Unit&) const {}
    __device__ __forceinline__ void done(const Unit&) const {}
};
struct SchedMerge {
    int nMr, G, c;
    __device__ bool next(int i, Unit& u) const { const int tile = (i / 3) * G + c, nb = i % 3; if (tile >= nMr * 4) return false; u.pm = nb * nMr + tile % nMr; u.pn = nb * 4 + tile / nMr; u.aux = nb; u.koff = 0; return true; }
    __device__ __forceinline__ void a_ready(const Unit&) const {}
    __device__ __forceinline__ void done(const Unit&) const {}
};
struct SchedMoe1 {
    const int* tile_exp; int t0, nt, G, c;
    __device__ bool next(int i, Unit& u) const { const int L = i * G + c; if (L >= nt * 28) return false; const int t = t0 + L % nt, j = L / nt; u.pm = t; u.pn = tile_exp[t] * 28 + j; u.aux = j; u.koff = 0; return true; }
    __device__ __forceinline__ void a_ready(const Unit&) const {}
    __device__ __forceinline__ void done(const Unit&) const {}
};
struct SchedMoe2 {
    const int* tile_exp; int t0, nt, G, c;
    __device__ bool next(int i, Unit& u) const { const int L = i * G + c; if (L >= nt * 4) return false; const int tl = L % nt, j = L / nt; u.pm = tl; u.pn = tile_exp[t0 + tl] * 4 + j; u.aux = (t0 + tl) * 4 + j; u.koff = 0; return true; }
    __device__ __forceinline__ void a_ready(const Unit&) const {}
    __device__ __forceinline__ void done(const Unit&) const {}
};
struct SchedMoe2K {
    const int* tile_exp; int t0, nt, G, c;
    __device__ bool next(int i, Unit& u) const { const int L = i * G + c; if (L >= nt * 16) return false; const int ks = L & 3, tl = (L >> 2) % nt, j = (L >> 2) / nt;
        u.pm = tl; u.pn = tile_exp[t0 + tl] * 4 + j; u.aux = (tl * 4 + j) * 4 + ks; u.koff = ks * 896; return true; }
    __device__ __forceinline__ void a_ready(const Unit&) const {}
    __device__ __forceinline__ void done(const Unit&) const {}
};

struct EpiStoreBf16 {
    static constexpr bool PERM = true, AFTER_DRAIN = false, INPLACE = false;
    bf16_t* O; int ldc; int mode;
    __device__ __forceinline__ void operator()(const f32x4 (&acc)[2][2][4][2], const Unit& u, int wr, int wc, int fr, int fq) const {
        float z0 = 0.f; asm volatile("" : "+v"(z0));
        const int rt = mode == 2 ? (u.aux >> 4) : (mode ? (u.aux >> 2) : u.pm), ct = mode == 2 ? ((u.aux >> 2) & 3) : (mode ? (u.aux & 3) : u.pn);
        const int row0 = rt * BM + wr * 64 + fr + (mode == 2 ? (u.aux & 3) * 2048 : 0), col0 = ct * BM + wc * 32 + 8 * fq;
#pragma unroll
        for (int ai = 0; ai < 2; ++ai)
#pragma unroll
            for (int m = 0; m < 4; ++m) { bf16_t* rowp = O + (size_t)(row0 + ai * HALF + m * 16) * ldc + col0;
#pragma unroll
                for (int bj = 0; bj < 2; ++bj) { const f32x4 v0 = acc[ai][bj][m][0] + z0, v1 = acc[ai][bj][m][1] + z0;
                    u32x4 w; w.x = cvt_pk_bf16(v0[0], v0[1]); w.y = cvt_pk_bf16(v0[2], v0[3]); w.z = cvt_pk_bf16(v1[0], v1[1]); w.w = cvt_pk_bf16(v1[2], v1[3]);
                    *(u32x4*)(rowp + bj * HALF) = w; } }
    }
};
struct EpiSwiGLU {
    static constexpr bool PERM = true, AFTER_DRAIN = false, INPLACE = false;
    bf16_t* O; int ldc; int mode; int t0;
    __device__ __forceinline__ void operator()(const f32x4 (&acc)[2][2][4][2], const Unit& u, int wr, int wc, int fr, int fq) const {
        const int rt = mode ? (u.pm - t0) : u.pm, ct = mode ? u.aux : u.pn;
        const int row0 = rt * BM + wr * 64 + fr, col0 = ct * HALF + wc * 32 + 8 * fq;
#pragma unroll
        for (int ai = 0; ai < 2; ++ai)
#pragma unroll
            for (int m = 0; m < 4; ++m) { bf16_t* rowp = O + (size_t)(row0 + ai * HALF + m * 16) * ldc + col0;
                float h[8];
#pragma unroll
                for (int n = 0; n < 2; ++n)
#pragma unroll
                    for (int j = 0; j < 4; ++j) { const float a = acc[ai][0][m][n][j], g = acc[ai][1][m][n][j]; h[n * 4 + j] = a * __builtin_amdgcn_rcpf(1.0f + __expf(-a)) * g; }
                u32x4 w; w.x = cvt_pk_bf16(h[0], h[1]); w.y = cvt_pk_bf16(h[2], h[3]); w.z = cvt_pk_bf16(h[4], h[5]); w.w = cvt_pk_bf16(h[6], h[7]);
                *(u32x4*)rowp = w; }
    }
};
struct EpiStoreF32 {
    static constexpr bool PERM = false, AFTER_DRAIN = false, INPLACE = false;
    float* C; int ldc;
    __device__ __forceinline__ void operator()(const f32x4 (&acc)[2][2][4][2], const Unit& u, int wr, int wc, int fr, int fq) const {
        const int row0 = u.pm * BM + wr * 64 + fr, col0 = u.pn * BM + wc * 32 + 4 * fq;
#pragma unroll
        for (int ai = 0; ai < 2; ++ai)
#pragma unroll
            for (int m = 0; m < 4; ++m) { float* rowp = C + (size_t)(row0 + ai * HALF + m * 16) * ldc + col0;
#pragma unroll
                for (int bj = 0; bj < 2; ++bj)
#pragma unroll
                    for (int n = 0; n < 2; ++n) *(f32x4*)(rowp + bj * HALF + n * 16) = acc[ai][bj][m][n]; }
    }
};
struct EpiMerge {
    static constexpr bool PERM = true, AFTER_DRAIN = false, INPLACE = true;
    const bf16_t* gate; int ldg;
    bf16_t* merged; int nMr;
    __device__ __forceinline__ bool inplace(f32x4 (&acc)[2][2][4][2], const Unit& u, int wr, int wc, int fr, int fq) const {
        const int nb = u.aux, rt = u.pm - nb * nMr, ct = u.pn - nb * 4;
        const int row0 = rt * BM + wr * 64 + fr, col0 = ct * BM + wc * 32 + 8 * fq;
        u32x4 ga[4][2], gb[4][2];
#define EM_LD(s, it, two) do { const bf16_t* gp_ = gate + (size_t)(row0 + ((it) >> 2) * HALF + ((it) & 3) * 16) * ldg + nb * 1024 + col0; \
            _Pragma("unroll") for (int bj_ = 0; bj_ < 2; ++bj_) { ga[s][bj_] = *(const u32x4*)(gp_ + bj_ * HALF); if (two) gb[s][bj_] = *(const u32x4*)(gp_ + 1024 + bj_ * HALF); } } while (0)
#define EM_UNPK(G_, W_) do { G_[0] = __uint_as_float(W_.x << 16); G_[1] = __uint_as_float(W_.x & 0xffff0000u); G_[2] = __uint_as_float(W_.y << 16); G_[3] = __uint_as_float(W_.y & 0xffff0000u); \
            G_[4] = __uint_as_float(W_.z << 16); G_[5] = __uint_as_float(W_.z & 0xffff0000u); G_[6] = __uint_as_float(W_.w << 16); G_[7] = __uint_as_float(W_.w & 0xffff0000u); } while (0)
        if (nb < 2) {
#pragma unroll
            for (int it = 0; it < 8; ++it) { const int s = it & 3, ai = it >> 2, m = it & 3;
                if (s == 0) { EM_LD(0, it, true); EM_LD(1, it + 1, true); EM_LD(2, it + 2, true); EM_LD(3, it + 3, true); }
#pragma unroll
                for (int bj = 0; bj < 2; ++bj) { float x[8], y[8]; const u32x4 wa = ga[s][bj], wb = gb[s][bj]; EM_UNPK(x, wa); EM_UNPK(y, wb);
#pragma unroll
                    for (int n = 0; n < 2; ++n)
#pragma unroll
                        for (int j = 0; j < 4; ++j) { const int e = n * 4 + j;
                            const float f = fmaxf(__builtin_amdgcn_rcpf(1.0f + __expf(-x[e])), 1e-18f) * fminf(1.0f + __expf(-y[e]), 1e18f);
                            acc[ai][bj][m][n][j] *= f; } } }
            return true;
        }
#pragma unroll
        for (int it = 0; it < 8; ++it) { const int s = it & 3, ai = it >> 2, m = it & 3; const size_t row = (size_t)(row0 + ai * HALF + m * 16);
            if (s == 0) { EM_LD(0, it, false); EM_LD(1, it + 1, false); EM_LD(2, it + 2, false); EM_LD(3, it + 3, false); }
#pragma unroll
            for (int bj = 0; bj < 2; ++bj) { const int col = col0 + bj * HALF; float x[8], v[8]; const u32x4 wa = ga[s][bj]; EM_UNPK(x, wa);
#pragma unroll
                for (int n = 0; n < 2; ++n)
#pragma unroll
                    for (int j = 0; j < 4; ++j) v[n * 4 + j] = acc[ai][bj][m][n][j] * fmaxf(__builtin_amdgcn_rcpf(1.0f + __expf(-x[n * 4 + j])), 1e-18f);
                u32x4 w; w.x = cvt_pk_bf16(v[0], v[1]); w.y = cvt_pk_bf16(v[2], v[3]); w.z = cvt_pk_bf16(v[4], v[5]); w.w = cvt_pk_bf16(v[6], v[7]);
                *(u32x4*)(merged + row * 1024 + col) = w; } }
#undef EM_LD
#undef EM_UNPK
        return false;
    }
};
}
#define XB_TMO      128
#define XB_XCNT(j)  (256  + 64 * (j))
#define XB_XSUB(j)  (1280 + 64 * (j))
#define XB_XGEN(j)  (2304 + 64 * (j))
#define XB_TOP      3328
#define XB_TOPGEN   3392
#define XCD_BAR_WORDS 3456
#define XB_SPIN_CAP (1u << 18)

__device__ __forceinline__ unsigned xb_ld(unsigned* p)              { return __hip_atomic_load(p, __ATOMIC_RELAXED, __HIP_MEMORY_SCOPE_AGENT); }
__device__ __forceinline__ unsigned xb_add(unsigned* p, unsigned v) { return __hip_atomic_fetch_add(p, v, __ATOMIC_RELAXED, __HIP_MEMORY_SCOPE_AGENT); }
__device__ __forceinline__ unsigned xb_xcc_id() { return (unsigned)__builtin_amdgcn_s_getreg((3 << 11) | 20) & 0xFu; }
#define XB_SPIN(cond, bar) do { unsigned _sp = 0; while (cond) { __builtin_amdgcn_s_sleep(1); \
    if ((++_sp & 255u) == 0u) { if (xb_ld(&(bar)[XB_TMO])) break; if (_sp > XB_SPIN_CAP) { atomicAdd(&(bar)[XB_TMO], 1u); break; } } } } while (0)

struct XcdBarrier {
    unsigned* bar; unsigned x;
    volatile LAS unsigned* st;
};

__device__ __forceinline__ XcdBarrier xcd_barrier_post(unsigned* bar, volatile LAS unsigned* st) {
    XcdBarrier b; b.bar = bar; b.x = xb_xcc_id(); b.st = st;
    if (threadIdx.x == 0) (void)xb_add(&bar[XB_XCNT(b.x)], 1u);
    return b;
}
__device__ __forceinline__ void xcd_barrier_complete(unsigned* bar, unsigned x, unsigned& nloc, unsigned& nx) {
    const unsigned G = gridDim.x * gridDim.y * gridDim.z;
    unsigned sum, cnt, mine, sp = 0u;
    for (;;) {
        sum = 0u; cnt = 0u; mine = 0u;
#pragma unroll
        for (unsigned j = 0; j < 16; ++j) { const unsigned c = xb_ld(&bar[XB_XCNT(j)]); sum += c; cnt += (c > 0u) ? 1u : 0u; mine = (j == x) ? c : mine; }
        if (sum == G) break;
        __builtin_amdgcn_s_sleep(1);
        if ((++sp & 255u) == 0u) { if (xb_ld(&bar[XB_TMO])) break; if (sp > XB_SPIN_CAP) { atomicAdd(&bar[XB_TMO], 1u); break; } }
    }
    nloc = mine > 0u ? mine : 1u; nx = cnt > 0u ? cnt : 1u;
}

__device__ __forceinline__ void xcd_barrier(const XcdBarrier& b) {
    asm volatile("s_waitcnt vmcnt(0)" ::: "memory");
    __syncthreads();
    if (threadIdx.x == 0) {
        unsigned* bar = b.bar;
        __builtin_amdgcn_s_waitcnt(0);
        unsigned nloc = b.st[0], nx = b.st[1];
        if (nloc == 0u) { xcd_barrier_complete(bar, b.x, nloc, nx); b.st[0] = nloc; b.st[1] = nx; }
        const unsigned old = xb_add(&bar[XB_XSUB(b.x)], 1u);
        const unsigned gen = old / nloc;
        if (old + 1u == (gen + 1u) * nloc) {
            __builtin_amdgcn_fence(__ATOMIC_RELEASE, "agent");
            asm volatile("s_waitcnt vmcnt(0)" ::: "memory");
            const unsigned og = xb_add(&bar[XB_TOP], 1u);
            const unsigned tg = og / nx;
            if (og + 1u == (tg + 1u) * nx) xb_add(&bar[XB_TOPGEN], 1u);
            else XB_SPIN(xb_ld(&bar[XB_TOPGEN]) == tg, bar);
            __builtin_amdgcn_fence(__ATOMIC_ACQUIRE, "agent");
            xb_add(&bar[XB_XGEN(b.x)], 1u);
            asm volatile("s_waitcnt vmcnt(0)" ::: "memory");
        } else {
            XB_SPIN(xb_ld(&bar[XB_XGEN(b.x)]) == gen, bar);
            __builtin_amdgcn_fence(__ATOMIC_ACQUIRE, "agent");
            asm volatile("s_waitcnt vmcnt(0)" ::: "memory");
        }
    }
    __syncthreads();
}

struct Ctx {
    const float* in[25]; float* out; unsigned char* ws;
    unsigned char* lds;
    int tid, lane, wave, wg, G;
};
#define IN_X 0
#define IN_C 1
#define IN_POS 2
#define IN_ADALN_W 3
#define IN_ADALN_B 4
#define IN_NORM_W 5
#define IN_W_IN 6
#define IN_GLA_UP 7
#define IN_GLA_BIAS 8
#define IN_GLA_NORM 9
#define IN_DIFF_LAMBDA 10
#define IN_DIFF_NORM 11
#define IN_GDN_CONV 12
#define IN_GDN_ALOG 13
#define IN_GDN_DTB 14
#define IN_GDN_NORM 15
#define IN_W_BRANCH 16
#define IN_W_OUT 17
#define IN_FFN_W1 18
#define IN_FFN_W3 19
#define IN_FFN_W2 20
#define IN_ROUTER 21
#define IN_MOE_W1 22
#define IN_MOE_W3 23
#define IN_MOE_W2 24

__device__ __forceinline__ void tr_item(const float* W, int K, int N, bf16* WT, int drow, float* scr, int k0, int n0, int lane) {
    const int kk0 = lane >> 3, nq = (lane & 7) * 4; f32x4 v[8];
    if (n0 + 32 <= N) {
#pragma unroll
        for (int i = 0; i < 8; ++i) v[i] = *(const f32x4*)(W + (size_t)(k0 + kk0 + 8 * i) * N + n0 + nq);
    } else {
#pragma unroll
        for (int i = 0; i < 8; ++i) { const float* p = W + (size_t)(k0 + kk0 + 8 * i) * N + n0 + nq;
            v[i].x = (n0 + nq < N) ? p[0] : 0.f; v[i].y = (n0 + nq + 1 < N) ? p[1] : 0.f; v[i].z = (n0 + nq + 2 < N) ? p[2] : 0.f; v[i].w = (n0 + nq + 3 < N) ? p[3] : 0.f; }
    }
#pragma unroll
    for (int i = 0; i < 8; ++i) { float* s = scr + (kk0 + 8 * i) * 33 + nq; s[0] = v[i].x; s[1] = v[i].y; s[2] = v[i].z; s[3] = v[i].w; }
    asm volatile("s_waitcnt lgkmcnt(0)" ::: "memory");
    const int c = lane & 7;
#pragma unroll
    for (int j = 0; j < 4; ++j) { const int n = (lane >> 3) + 8 * j; const float* s = scr + (8 * c) * 33 + n;
        u32x4 o; o.x = cvtpk(s[0 * 33], s[1 * 33]); o.y = cvtpk(s[2 * 33], s[3 * 33]); o.z = cvtpk(s[4 * 33], s[5 * 33]); o.w = cvtpk(s[6 * 33], s[7 * 33]);
        *(u32x4*)(WT + (size_t)(drow + n) * K + k0 + 8 * c) = o; }
    asm volatile("s_waitcnt lgkmcnt(0)" ::: "memory");
}
__device__ __forceinline__ void tr_matrix(Ctx& C, const float* W, int K, int N, int Npad, bf16* WT, int drow0, bool swi, int& base) {
    float* scr = (float*)(C.lds + C.wave * 8704);
    const int nblk = Npad / 32, nitems = (K / 64) * nblk, gw = C.wg * NWAVES + C.wave, NGW = C.G * NWAVES;
    int first = (gw - base % NGW + NGW) % NGW;
    for (int it = first; it < nitems; it += NGW) { const int kb = it / nblk, nb = it % nblk, n0 = nb * 32;
        const int drow = drow0 + (swi ? (n0 / 128) * 256 + (n0 % 128) : n0);
        tr_item(W, K, N, WT, drow, scr, kb * 64, n0, C.lane); }
    base += nitems;
}
__device__ __forceinline__ void convert_mixer_weights(Ctx& C, int l, int& base) {
    tr_matrix(C, C.in[IN_W_IN] + (size_t)l * DM * INC, DM, INC, LDP, (bf16*)(C.ws + WS_WIN), 0, false, base);
    for (int nb = 0; nb < 3; ++nb) tr_matrix(C, C.in[IN_W_BRANCH] + (size_t)(l * 3 + nb) * 512 * DM, 512, DM, DM, (bf16*)(C.ws + WS_WB) + (size_t)nb * 1024 * 512, 0, false, base);
    tr_matrix(C, C.in[IN_W_OUT] + (size_t)l * DM * DM, DM, DM, DM, (bf16*)(C.ws + WS_WO), 0, false, base);
}
__device__ __forceinline__ void convert_ffn_weights(Ctx& C, int& base) {
    tr_matrix(C, C.in[IN_FFN_W1], DM, DFF, DFF, (bf16*)(C.ws + WS_W13), 0, true, base);
    tr_matrix(C, C.in[IN_FFN_W3], DM, DFF, DFF, (bf16*)(C.ws + WS_W13), 128, true, base);
    tr_matrix(C, C.in[IN_FFN_W2], DFF, DM, DM, (bf16*)(C.ws + WS_W2), 0, false, base);
}
__device__ __forceinline__ void convert_moe_weights(Ctx& C, int& base) {
    for (int e = 0; e < NEXP; ++e) {
        tr_matrix(C, C.in[IN_MOE_W1] + (size_t)e * DM * DEXP, DM, DEXP, DEXP, (bf16*)(C.ws + WS_MW13) + (size_t)e * 2 * DEXP * DM, 0, true, base);
        tr_matrix(C, C.in[IN_MOE_W3] + (size_t)e * DM * DEXP, DM, DEXP, DEXP, (bf16*)(C.ws + WS_MW13) + (size_t)e * 2 * DEXP * DM, 128, true, base);
        tr_matrix(C, C.in[IN_MOE_W2] + (size_t)e * DEXP * DM, DEXP, DM, DM, (bf16*)(C.ws + WS_MW2) + (size_t)e * DM * DEXP, 0, false, base);
    }
}

__device__ __forceinline__ void mod_partials(Ctx& C) {
    float* sm = (float*)(C.lds + 8 * 8704);
    float* modp = (float*)(C.ws + WS_MODP);
    for (int item = C.wg; item < 192; item += C.G) {
        const int l = item / 96, r = item % 96, ec = r / 8, dp = r % 8;
        __syncthreads();
        { const int b = C.tid >> 7, dd = C.tid & 127; const float cv = C.in[IN_C][b * DM + dp * 128 + dd]; sm[C.tid] = cv / (1.0f + __expf(-cv)); }
        __syncthreads();
        const int e = ec * 512 + C.tid; float a0 = 0.f, a1 = 0.f, a2 = 0.f, a3 = 0.f;
        const float* wp = C.in[IN_ADALN_W] + ((size_t)l * DM + dp * 128) * 6144 + e;
#pragma unroll 32
        for (int dd = 0; dd < 128; ++dd) { const float w = wp[(size_t)dd * 6144]; a0 += sm[dd] * w; a1 += sm[128 + dd] * w; a2 += sm[256 + dd] * w; a3 += sm[384 + dd] * w; }
        float* o = modp + ((size_t)(dp * 2 + l) * 4) * 6144 + e;
        o[0] = a0; o[6144] = a1; o[2 * 6144] = a2; o[3 * 6144] = a3;
    }
}
__device__ __forceinline__ float mod_val(const Ctx& C, int l, int b, int k, int c) {
    const float* modp = (const float*)(C.ws + WS_MODP);
    float s = C.in[IN_ADALN_B][l * 6144 + k * 1024 + c];
#pragma unroll
    for (int dp = 0; dp < 8; ++dp) s += modp[((size_t)(dp * 2 + l) * 4 + b) * 6144 + k * 1024 + c];
    return s;
}

__device__ __forceinline__ float mod_fin(const Ctx& C, int l, int b, int k, int c) { return ((const float*)(C.ws + WS_MODF))[(size_t)(l * 4 + b) * 6144 + k * 1024 + c]; }

__device__ __forceinline__ void phase_norm_in(Ctx& C, const float* x, int l) {
    float* vA = (float*)C.lds; float* vB = vA + 1024;
    const int rows_per_wg = TOK / C.G;
    const int r0 = C.wg * rows_per_wg, b = r0 / SEQ;
    __syncthreads();
    for (int c = C.tid; c < DM; c += NTHREADS) { vA[c] = C.in[IN_NORM_W][(l * 4 + 0) * DM + c] * (1.0f + mod_val(C, l, b, 1, c)); vB[c] = mod_val(C, l, b, 0, c); }
    __syncthreads();
    for (int i = C.wg * NTHREADS + C.tid; i < 2 * 4 * 6144; i += C.G * NTHREADS) { const int l2 = i / (4 * 6144), r2 = i % (4 * 6144), b2 = r2 / 6144, e2 = r2 % 6144;
        ((float*)(C.ws + WS_MODF))[i] = mod_val(C, l2, b2, e2 >> 10, e2 & 1023); }
    if (C.wg == 0 && C.tid < 2) { const float* lp = C.in[IN_DIFF_LAMBDA] + C.tid * 256; float s1 = 0.f, s2 = 0.f;
        for (int i = 0; i < 64; ++i) { s1 += lp[i] * lp[64 + i]; s2 += lp[128 + i] * lp[192 + i]; }
        ((float*)(C.ws + WS_MODF))[49152 + C.tid] = __expf(s1) - __expf(s2) + (0.8f - 0.6f * __expf(-0.3f * (float)C.tid)); }
    bf16* H = (bf16*)(C.ws + WS_H);
    for (int r = r0 + C.wave; r < r0 + rows_per_wg; r += NWAVES) {
        const f32x4* xr = (const f32x4*)(x + (size_t)r * DM) + C.lane; f32x4 v[4]; float s = 0.f;
#pragma unroll
        for (int j = 0; j < 4; ++j) { v[j] = xr[64 * j]; s += v[j].x * v[j].x + v[j].y * v[j].y + v[j].z * v[j].z + v[j].w * v[j].w; }
        const float rs = rsqrtf(wave_sum(s) * (1.0f / DM) + EPS);
        u32x2* o = (u32x2*)(H + (size_t)r * DM) + C.lane;
#pragma unroll
        for (int j = 0; j < 4; ++j) { const int c = 4 * C.lane + 256 * j; const f32x4 a = *(const f32x4*)(vA + c), bb = *(const f32x4*)(vB + c);
            u32x2 w; w.x = cvtpk(v[j].x * rs * a.x + bb.x, v[j].y * rs * a.y + bb.y); w.y = cvtpk(v[j].z * rs * a.z + bb.z, v[j].w * rs * a.w + bb.w); o[64 * j] = w; }
    }
}
__device__ __forceinline__ void phase_resnorm(Ctx& C, int row_lo, int nrows, const float* xold, const float* ysrc, int yrow0, bool from_slots,
                                              int l, int kg, int nwres, bool do_h, int ln, int ksc, int ksh, int nwn, bool do_route, int grp0) {
    float* vG = (float*)C.lds; float* vA = vG + 1024; float* vB = vA + 1024; float* Wr = vB + 1024;
    int* cnt = (int*)(Wr + 8192);
    const int rows_per_wg = nrows / C.G, r0 = row_lo + C.wg * rows_per_wg, b = r0 / SEQ;
    __syncthreads();
    for (int c = C.tid; c < DM; c += NTHREADS) {
        vG[c] = mod_fin(C, l, b, kg, c) * C.in[IN_NORM_W][(l * 4 + nwres) * DM + c];
        if (do_h) { vA[c] = C.in[IN_NORM_W][(ln * 4 + nwn) * DM + c] * (1.0f + mod_fin(C, ln, b, ksc, c)); vB[c] = mod_fin(C, ln, b, ksh, c); } }
    if (do_route) { for (int i = C.tid; i < DM * NEXP; i += NTHREADS) Wr[i] = C.in[IN_ROUTER][i]; if (C.tid < 8) cnt[C.tid] = 0; }
    __syncthreads();
    bf16* H = (bf16*)(C.ws + WS_H);
    const uint4* route = (const uint4*)(C.ws + WS_ROUTE); const int* slotrow = (const int*)(C.ws + WS_SLOTROW); const bf16* ys = (const bf16*)(C.ws + WS_ASORT);
    struct RowIn { f32x4 y[4]; f32x4 x[4]; u32x2 a[4], b[4]; float w0, w1; int s0, s1; };
    const bf16* mp = (const bf16*)(C.ws + WS_MPART);
    auto load_row = [&](RowIn& in, int r) {
        if (!from_slots) { const u32x2* yr = (const u32x2*)((const bf16*)ysrc + (size_t)(r - yrow0) * DM) + C.lane;
#pragma unroll
            for (int j = 0; j < 4; ++j) in.a[j] = yr[64 * j]; }
        else { const uint4 rt = route[r]; in.w0 = __uint_as_float(rt.z); in.w1 = __uint_as_float(rt.w);
            const int s0 = slotrow[2 * r], s1 = slotrow[2 * r + 1]; in.s0 = s0; in.s1 = s1;
            const u32x2* y0 = (const u32x2*)((s0 < 65536 ? ys : mp - (size_t)65536 * DM) + (size_t)s0 * DM) + C.lane; const u32x2* y1 = (const u32x2*)((s1 < 65536 ? ys : mp - (size_t)65536 * DM) + (size_t)s1 * DM) + C.lane;
#pragma unroll
            for (int j = 0; j < 4; ++j) { in.a[j] = y0[64 * j]; in.b[j] = y1[64 * j]; } }
        const f32x4* xr = (const f32x4*)(xold + (size_t)r * DM) + C.lane;
#pragma unroll
        for (int j = 0; j < 4; ++j) in.x[j] = xr[64 * j];
    };
    auto proc_row = [&](RowIn& in, int r) {
        f32x4 y[4]; float s = 0.f;
        if (!from_slots) {
#pragma unroll
            for (int j = 0; j < 4; ++j) { const u32x2 a = in.a[j]; y[j].x = bflo(a.x); y[j].y = bfhi(a.x); y[j].z = bflo(a.y); y[j].w = bfhi(a.y); } }
        else { const float w0 = in.w0, w1 = in.w1;
#pragma unroll
            for (int j = 0; j < 4; ++j) { const u32x2 a = in.a[j], bb = in.b[j];
                y[j].x = w0 * bflo(a.x) + w1 * bflo(bb.x); y[j].y = w0 * bfhi(a.x) + w1 * bfhi(bb.x); y[j].z = w0 * bflo(a.y) + w1 * bflo(bb.y); y[j].w = w0 * bfhi(a.y) + w1 * bfhi(bb.y); }
#pragma unroll
            for (int sl = 0; sl < 2; ++sl) { const int sr_ = sl ? in.s1 : in.s0; const float ww = sl ? w1 : w0;
                if (sr_ >= 65536) { for (int ks = 1; ks < 4; ++ks) { const u32x2* yp = (const u32x2*)(mp + ((size_t)ks * 2048 + (sr_ - 65536)) * DM) + C.lane;
#pragma unroll
                        for (int j = 0; j < 4; ++j) { const u32x2 a = yp[64 * j]; y[j].x += ww * bflo(a.x); y[j].y += ww * bfhi(a.x); y[j].z += ww * bflo(a.y); y[j].w += ww * bfhi(a.y); } } } } }
#pragma unroll
        for (int j = 0; j < 4; ++j) s += y[j].x * y[j].x + y[j].y * y[j].y + y[j].z * y[j].z + y[j].w * y[j].w;
        const float rs = rsqrtf(wave_sum(s) * (1.0f / DM) + EPS);
        f32x4* xo = (f32x4*)(C.out + (size_t)r * DM) + C.lane;
        f32x4 xn[4]; float s2 = 0.f;
#pragma unroll
        for (int j = 0; j < 4; ++j) { const int c = 4 * C.lane + 256 * j; const f32x4 g = *(const f32x4*)(vG + c); const f32x4 xv = in.x[j];
            xn[j].x = xv.x + g.x * (y[j].x * rs); xn[j].y = xv.y + g.y * (y[j].y * rs); xn[j].z = xv.z + g.z * (y[j].z * rs); xn[j].w = xv.w + g.w * (y[j].w * rs);
            xo[64 * j] = xn[j]; s2 += xn[j].x * xn[j].x + xn[j].y * xn[j].y + xn[j].z * xn[j].z + xn[j].w * xn[j].w; }
        if (do_h) {
            const float rs2 = rsqrtf(wave_sum(s2) * (1.0f / DM) + EPS);
            u32x2* o = (u32x2*)(H + (size_t)r * DM) + C.lane; float lg[8];
#pragma unroll
            for (int e = 0; e < 8; ++e) lg[e] = 0.f;
#pragma unroll
            for (int j = 0; j < 4; ++j) { const int c = 4 * C.lane + 256 * j; const f32x4 a = *(const f32x4*)(vA + c), bb = *(const f32x4*)(vB + c);
                float hv[4]; hv[0] = xn[j].x * rs2 * a.x + bb.x; hv[1] = xn[j].y * rs2 * a.y + bb.y; hv[2] = xn[j].z * rs2 * a.z + bb.z; hv[3] = xn[j].w * rs2 * a.w + bb.w;
                u32x2 w; w.x = cvtpk(hv[0], hv[1]); w.y = cvtpk(hv[2], hv[3]); o[64 * j] = w;
                if (do_route) {
#pragma unroll
                    for (int q = 0; q < 4; ++q) { const f32x4 wa = *(const f32x4*)(Wr + (c + q) * 8), wb = *(const f32x4*)(Wr + (c + q) * 8 + 4);
                        lg[0] += hv[q] * wa.x; lg[1] += hv[q] * wa.y; lg[2] += hv[q] * wa.z; lg[3] += hv[q] * wa.w; lg[4] += hv[q] * wb.x; lg[5] += hv[q] * wb.y; lg[6] += hv[q] * wb.z; lg[7] += hv[q] * wb.w; } } }
            if (do_route) {
#pragma unroll
                for (int e = 0; e < 8; ++e) lg[e] = wave_sum(lg[e]);
                int i0 = 0; float v0 = lg[0];
#pragma unroll
                for (int e = 1; e < 8; ++e) if (lg[e] > v0) { v0 = lg[e]; i0 = e; }
                int i1 = -1; float v1 = -3.0e38f;
#pragma unroll
                for (int e = 0; e < 8; ++e) if (e != i0 && lg[e] > v1) { v1 = lg[e]; i1 = e; }
                const float w0 = 1.0f / (1.0f + __expf(v1 - v0)), w1 = 1.0f - w0;
                if (C.lane == 0) { const int p0 = atomicAdd(&cnt[i0], 1), p1 = atomicAdd(&cnt[i1], 1);
                    ((uint4*)(C.ws + WS_ROUTE))[r] = make_uint4((unsigned)i0, (unsigned)i1, __float_as_uint(w0), __float_as_uint(w1));
                    int* lpos = (int*)(C.ws + WS_LPOS); lpos[2 * r] = p0; lpos[2 * r + 1] = p1; }
            }
        }
    };
    { RowIn A, B; const int rend = r0 + rows_per_wg; int r = r0 + C.wave;
        load_row(A, r);
        for (; r < rend; r += 2 * NWAVES) { const int r2 = r + NWAVES, r3 = r + 2 * NWAVES;
            if (r2 < rend) load_row(B, r2);
            proc_row(A, r);
            if (r2 < rend) { if (r3 < rend) load_row(A, r3); proc_row(B, r2); } } }
    __syncthreads();
    if (do_route) { if (C.tid < 8) ((int*)(C.ws + WS_GCNT))[(grp0 + C.wg) * 8 + C.tid] = cnt[C.tid]; __syncthreads(); }
}

namespace ck {
using bf16x8 = __attribute__((ext_vector_type(8))) short;
using f32x16 = __attribute__((ext_vector_type(16))) float;
__device__ __forceinline__ int crow(int r, int hi) { return (r & 3) + 8 * (r >> 2) + 4 * hi; }
template <int KS> __device__ __forceinline__ void mma(f32x16& acc, const bf16* ap, const bf16* bp) {
#pragma unroll
    for (int s = 0; s < KS; ++s) { const bf16x8 a = *(const bf16x8*)(ap + 16 * s); const bf16x8 b = *(const bf16x8*)(bp + 16 * s); acc = __builtin_amdgcn_mfma_f32_32x32x16_bf16(a, b, acc, 0, 0, 0); }
}
__device__ __forceinline__ void settle() { asm volatile("s_nop 15\n\ts_nop 3" ::: "memory"); }
__device__ __forceinline__ f32x16 zero16() { f32x16 z;
#pragma unroll
    for (int i = 0; i < 16; ++i) z[i] = 0.f;
    return z; }
}

__device__ __forceinline__ void proj_tail_unit(Ctx& C, int hb) {
    int tid_ = threadIdx.x; asm volatile("" : "+v"(tid_));
    const int tid = tid_, lane = tid & 63, wv = __builtin_amdgcn_readfirstlane(tid >> 6), r32 = lane & 31, hi = lane >> 5, rt = wv & 1, ks = wv >> 1;
    const bf16* ap = (const bf16*)(C.ws + WS_H) + ((size_t)hb * HBR + C.wg * 64 + rt * 32 + r32) * DM + ks * 256 + 8 * hi;
    const bf16* bp = (const bf16*)(C.ws + WS_WIN) + (size_t)(8192 + r32) * DM + ks * 256 + 8 * hi;
    ck::f32x16 a0 = ck::zero16(), a1 = ck::zero16();
#pragma unroll
    for (int hf = 0; hf < 2; ++hf) {
        ck::bf16x8 av[8], b0v[8], b1v[8];
#pragma unroll
        for (int s = 0; s < 8; ++s) { av[s] = *(const ck::bf16x8*)(ap + 16 * (8 * hf + s)); b0v[s] = *(const ck::bf16x8*)(bp + 16 * (8 * hf + s)); b1v[s] = *(const ck::bf16x8*)(bp + 32 * DM + 16 * (8 * hf + s)); }
        __builtin_amdgcn_sched_barrier(0);
#pragma unroll
        for (int s = 0; s < 8; ++s) { a0 = __builtin_amdgcn_mfma_f32_32x32x16_bf16(av[s], b0v[s], a0, 0, 0, 0); a1 = __builtin_amdgcn_mfma_f32_32x32x16_bf16(av[s], b1v[s], a1, 0, 0, 0); }
        __builtin_amdgcn_sched_barrier(0);
    }
    float* red = (float*)C.lds;
    __syncthreads();
#pragma unroll
    for (int i = 0; i < 16; ++i) { red[(((ks * 2 + rt) * 2 + 0) * 16 + i) * 64 + lane] = a0[i]; red[(((ks * 2 + rt) * 2 + 1) * 16 + i) * 64 + lane] = a1[i]; }
    __syncthreads();
    bf16* proj = (bf16*)(C.ws + WS_PROJ) + (size_t)(C.wg * 64) * LDP + 8192;
#pragma unroll
    for (int q = 0; q < 8; ++q) { const int idx = q * 512 + tid, ln = idx & 63, i = (idx >> 6) & 15, nt = (idx >> 10) & 1, r = idx >> 11;
        float s = 0.f;
#pragma unroll
        for (int k2 = 0; k2 < 4; ++k2) s += red[(((k2 * 2 + r) * 2 + nt) * 16 + i) * 64 + ln];
        const int col = nt * 32 + (ln & 31), row = r * 32 + ck::crow(i, ln >> 5);
        if (col < 48) proj[(size_t)row * LDP + col] = f2bf(s); }
    __syncthreads();
}

__device__ __forceinline__ void rope_item(Ctx& C, int hb, int item) {
    bf16* proj = (bf16*)(C.ws + WS_PROJ); const WT wt = wt_make(C.ws);
    const int tpw = 8, gw = item * NWAVES + C.wave, lane = C.lane;
    const float inv_f = __expf(-13.122363377404328f * (float)(lane & 7) * 0.125f);
    const float pos = (float)((const int*)C.in[IN_POS])[hb * HBR + gw * tpw + (lane >> 3)]; float sn, cs; sincosf(pos * inv_f, &sn, &cs);
    u32x4 w0[8], w1[8];
#pragma unroll
    for (int tk = 0; tk < 8; ++tk) { const bf16* hp = proj + (size_t)(gw * tpw + tk) * LDP + (lane < 8 ? C_DQ + lane * 64 : C_DK + (lane & 7) * 64);
        w0[tk] = (u32x4){0, 0, 0, 0}; w1[tk] = (u32x4){0, 0, 0, 0}; if (lane < 16) { w0[tk] = *(const u32x4*)hp; w1[tk] = *(const u32x4*)(hp + 8); } }
#pragma unroll
    for (int tk = 0; tk < 8; ++tk) { bf16* hp = proj + (size_t)(gw * tpw + tk) * LDP + (lane < 8 ? C_DQ + lane * 64 : C_DK + (lane & 7) * 64);
        float x1[8], x2[8], o1[8], o2[8]; unpack8(w0[tk], x1); unpack8(w1[tk], x2);
#pragma unroll
        for (int i = 0; i < 8; ++i) { const float c_ = __shfl(cs, tk * 8 + i), s_ = __shfl(sn, tk * 8 + i); o1[i] = x1[i] * c_ - x2[i] * s_; o2[i] = x2[i] * c_ + x1[i] * s_; }
        if (lane < 16) { wt16(wt, hp, pack8(o1)); wt16(wt, hp + 8, pack8(o2)); } }
}

__device__ __forceinline__ void gdn_prep_setup(Ctx& C, int l) {
    bf16* cwl = (bf16*)(C.lds + 122880);
    __syncthreads();
    for (int i = C.tid; i < 4 * 1536; i += NTHREADS) cwl[i] = f2bf(C.in[IN_GDN_CONV][(size_t)l * 4 * 1536 + i]);
    __syncthreads();
}
__device__ __forceinline__ void gdn_prep_unit(Ctx& C, int uidx, int l) {
    const int cn = uidx & 127, h = (uidx >> 7) & 3, sq = uidx >> 9;
    int tid_ = threadIdx.x; asm volatile("" : "+v"(tid_));
    const int tid = tid_, lane = tid & 63, wv = __builtin_amdgcn_readfirstlane(tid >> 6), r32 = lane & 31, hi = lane >> 5;
    bf16* Kn = (bf16*)C.lds; bf16* Qn = Kn + 64 * 136; bf16* Vn = Qn + 64 * 136;
    float* KKr = (float*)(C.lds + 51200); float* QKr = KKr + 64 * 68; float* MM = QKr + 64 * 68;
    float* gl = MM + 2 * 64 * 68; float* be = gl + 128; float* bq = be + 128; float* eb = bq + 128;
    const bf16* proj = (const bf16*)(C.ws + WS_PROJ) + (size_t)sq * SEQ * LDP;
    const int rowb = sq * SEQ + cn * 64;
    { const int lr = tid >> 3, c16 = (tid & 7) * 16, tpos = cn * 64 + lr; const bf16* cwl = (const bf16*)(C.lds + 122880);
        u32x4 raw[3][4][2];
#pragma unroll
        for (int mat = 0; mat < 3; ++mat)
#pragma unroll
            for (int j = 0; j < 4; ++j) { const int tt = tpos - 1 + j; const bool ok = (tt >= 0 && tt < SEQ); const bf16* p = proj + (size_t)(ok ? tt : tpos) * LDP + C_NQ + mat * 512 + h * 128 + c16;
                const u32x4 w0 = *(const u32x4*)p, w1 = *(const u32x4*)(p + 8); raw[mat][j][0] = ok ? w0 : (u32x4){0, 0, 0, 0}; raw[mat][j][1] = ok ? w1 : (u32x4){0, 0, 0, 0}; }
#pragma unroll
        for (int mat = 0; mat < 3; ++mat) {
            const int col = mat * 512 + h * 128 + c16; float acc[16];
#pragma unroll
            for (int i = 0; i < 16; ++i) acc[i] = 0.f;
#pragma unroll
            for (int j = 0; j < 4; ++j) { float xv[16], wv_[16]; unpack8(raw[mat][j][0], xv); unpack8(raw[mat][j][1], xv + 8);
                unpack8(*(const u32x4*)(cwl + j * 1536 + col), wv_); unpack8(*(const u32x4*)(cwl + j * 1536 + col + 8), wv_ + 8);
#pragma unroll
                for (int i = 0; i < 16; ++i) acc[i] += wv_[i] * xv[i]; }
            float ss = 0.f;
#pragma unroll
            for (int i = 0; i < 16; ++i) { acc[i] = siluf_(acc[i]); ss += acc[i] * acc[i]; }
            if (mat < 2) { ss = grp8_sum(ss); const float sc = rsqrtf(ss + EPS) * (mat == 0 ? 0.08838834764831845f : 1.0f);
#pragma unroll
                for (int i = 0; i < 16; ++i) acc[i] *= sc; }
            const u32x4 o0 = pack8(acc), o1 = pack8(acc + 8);
            if (mat == 0) { *(u32x4*)(Qn + lr * 136 + c16) = o0; *(u32x4*)(Qn + lr * 136 + c16 + 8) = o1;
                bf16* qg = (bf16*)(C.ws + WS_QN) + (size_t)(rowb + lr) * 512 + h * 128 + c16; *(u32x4*)qg = o0; *(u32x4*)(qg + 8) = o1; }
            else if (mat == 1) { *(u32x4*)(Kn + lr * 136 + c16) = o0; *(u32x4*)(Kn + lr * 136 + c16 + 8) = o1; }
            else { *(u32x4*)(Vn + lr * 128 + c16) = o0; *(u32x4*)(Vn + lr * 128 + c16 + 8) = o1; }
        } }
    if (tid < 128) { const int d = tid >> 6, i = tid & 63; const bf16* p = proj + (size_t)(cn * 64 + i) * LDP;
        const float bl = bf2f(p[C_NBF + d * 4 + h]), al = bf2f(p[C_NAF + d * 4 + h]);
        const float z = al + C.in[IN_GDN_DTB][(l * 2 + d) * 4 + h]; const float sp = z > 20.f ? z : log1pf(__expf(z));
        gl[d * 64 + i] = -__expf(C.in[IN_GDN_ALOG][(l * 2 + d) * 4 + h]) * sp; be[d * 64 + i] = sigmoidf_(bl); }
    __syncthreads();
    if (tid < 128) { const int d = tid >> 6, ip = tid & 63; float s = 0.f;
        for (int jp = 0; jp <= ip; ++jp) s += gl[d * 64 + (d ? 63 - jp : jp)];
        bq[d * 64 + ip] = s; eb[d * 64 + ip] = __expf(s);
        ((float*)(C.ws + WS_GB))[((size_t)d * 1024 + uidx) * 64 + ip] = s; }
    { const int w4 = wv & 3, ti = w4 >> 1, tj = w4 & 1; ck::f32x16 acc = ck::zero16();
        const bf16* ap = Kn + (32 * tj + r32) * 136 + 8 * hi; const bf16* bp = (wv < 4 ? Kn : Qn) + (32 * ti + r32) * 136 + 8 * hi;
        ck::mma<8>(acc, ap, bp);
        float* dst = (wv < 4 ? KKr : QKr) + (32 * ti + r32) * 68 + 32 * tj + 4 * hi;
#pragma unroll
        for (int g = 0; g < 4; ++g) *(f32x4*)(dst + 8 * g) = (f32x4){acc[4 * g], acc[4 * g + 1], acc[4 * g + 2], acc[4 * g + 3]}; }
    __syncthreads();
    { const int d = tid >> 8, t = tid & 255, ip = t >> 2, jp0 = (t & 3) * 16, i = d ? 63 - ip : ip; const float bi = bq[d * 64 + ip], bti = be[d * 64 + i]; float at[16];
#pragma unroll
        for (int jj = 0; jj < 16; ++jj) { const int jp = jp0 + jj, j = d ? 63 - jp : jp; const float gam = (jp <= ip) ? __expf(bi - bq[d * 64 + jp]) : 0.f;
            MM[(d * 64 + ip) * 68 + jp] = (jp < ip) ? bti * KKr[i * 68 + j] * gam : 0.f; at[jj] = QKr[i * 68 + j] * gam; }
        bf16* ag = (bf16*)(C.ws + WS_ATT) + (((size_t)d * 1024 + uidx) * 64 + ip) * 64 + jp0; *(u32x4*)ag = pack8(at); *(u32x4*)(ag + 8) = pack8(at + 8); }
    { const int dd = tid & 127, jb = tid >> 7; float kv[16];
#pragma unroll
        for (int jj = 0; jj < 16; ++jj) kv[jj] = bf2f(Kn[(jb * 16 + jj) * 136 + dd]);
        bf16* kg = (bf16*)(C.ws + WS_KT) + ((size_t)uidx * 128 + dd) * 64 + jb * 16; *(u32x4*)kg = pack8(kv); *(u32x4*)(kg + 8) = pack8(kv + 8); }
    __syncthreads();
    if (wv < 4) { typedef float f32x2 __attribute__((ext_vector_type(2)));
        const int d = wv >> 1, t = tid & 127; const float* Mr = MM + d * 64 * 68; f32x2 x[64];
#pragma unroll
        for (int i = 0; i < 64; ++i) x[i] = (f32x2){0.f, 0.f};
        bf16* ogu = (bf16*)(C.ws + WS_U) + (((size_t)d * 1024 + uidx) * 128 + t) * 64;            bf16* ogw = (bf16*)(C.ws + WS_W) + ((size_t)d * HBR + rowb) * 512 + h * 128 + t;
        int i = d ? 63 : 0; const int istep = d ? -1 : 1;
        f32x4 mb[2][4][2];
#define SV_LOAD(bf, bk, ch) do { _Pragma("unroll") for (int r_ = 0; r_ < 4; ++r_) _Pragma("unroll") for (int q_ = 0; q_ < 2; ++q_) mb[bf][r_][q_] = *(const f32x4*)(Mr + (4 * (bk) + r_) * 68 + 8 * (ch) + 4 * q_); } while (0)
        SV_LOAD(0, 1, 0);
#pragma unroll
        for (int blk = 0; blk < 16; ++blk) { asm volatile("" : "+v"(i));
            const int nch = (blk + 1) / 2, sb = (blk / 2) * ((blk + 1) / 2);
            f32x2 a[4];
#pragma unroll
            for (int r = 0; r < 4; ++r) { const int ii = i + r * istep; const float bt = be[d * 64 + ii]; a[r] = (f32x2){bt * bf2f(Vn[ii * 128 + t]), bt * eb[d * 64 + 4 * blk + r] * bf2f(Kn[ii * 136 + t])}; }
            const f32x4 m1 = *(const f32x4*)(Mr + (4 * blk + 1) * 68 + 4 * blk), m2 = *(const f32x4*)(Mr + (4 * blk + 2) * 68 + 4 * blk), m3 = *(const f32x4*)(Mr + (4 * blk + 3) * 68 + 4 * blk);
#pragma unroll
            for (int ch = 0; ch < nch; ++ch) { const int bf = (sb + ch) & 1;
                if (ch + 1 < nch) SV_LOAD(bf ^ 1, blk, ch + 1); else if (blk + 1 < 16) SV_LOAD(bf ^ 1, blk + 1, 0);
#pragma unroll
                for (int r = 0; r < 4; ++r)
#pragma unroll
                    for (int q = 0; q < 2; ++q) { const f32x4 m = mb[bf][r][q];
                        a[r] -= m.x * x[8 * ch + 4 * q]; a[r] -= m.y * x[8 * ch + 4 * q + 1]; a[r] -= m.z * x[8 * ch + 4 * q + 2]; a[r] -= m.w * x[8 * ch + 4 * q + 3]; } }
            a[1] -= m1.x * a[0]; a[2] -= m2.x * a[0]; a[2] -= m2.y * a[1]; a[3] -= m3.x * a[0]; a[3] -= m3.y * a[1]; a[3] -= m3.z * a[2];
#pragma unroll
            for (int r = 0; r < 4; ++r) { const int ii = i + r * istep; x[4 * blk + r] = a[r]; ogw[(size_t)ii * 512] = f2bf(a[r].y); }
            { u32x2 uw; uw.x = cvtpk(a[0].x, a[1].x); uw.y = cvtpk(a[2].x, a[3].x); *(u32x2*)(ogu + 4 * blk) = uw; }
            i += 4 * istep; }
#undef SV_LOAD
    }
    __syncthreads();
}

__device__ __forceinline__ void gdn_scan_unit(Ctx& C, int unit) {
    const int vs = unit & 1, dir = (unit >> 1) & 1, h = (unit >> 2) & 3, sq = unit >> 4;
    int tid_ = threadIdx.x; asm volatile("" : "+v"(tid_));
    const int tid = tid_, lane = tid & 63, wv = __builtin_amdgcn_readfirstlane(tid >> 6), r32 = lane & 31, hi = lane >> 5;
    bf16* Wc = (bf16*)C.lds; bf16* Qc = Wc + 64 * 136; bf16* KTc = Qc + 64 * 136; bf16* ATTc = KTc + 128 * 72; bf16* Uc = ATTc + 64 * 72;
    bf16* ST = Uc + 64 * 72; bf16* VNT = ST + 64 * 136; bf16* VN2T = VNT + 64 * 72; float* bv = (float*)(VN2T + 64 * 72); float* ebv = bv + 64; float* e2 = ebv + 64;
    const bf16* Wg = (const bf16*)(C.ws + WS_W) + (size_t)dir * HBR * 512; const bf16* Ug = (const bf16*)(C.ws + WS_U) + (size_t)dir * 1024 * 128 * 64;
    const bf16* Qg = (const bf16*)(C.ws + WS_QN); const bf16* KTg = (const bf16*)(C.ws + WS_KT); const bf16* ATg = (const bf16*)(C.ws + WS_ATT) + (size_t)dir * 1024 * 4096;
    const float* GBg = (const float*)(C.ws + WS_GB) + (size_t)dir * 1024 * 64;
    bf16* og = (bf16*)(C.ws + WS_OGDN) + (size_t)dir * HBR * 512 + h * 128 + vs * 64;
    struct Pre { u32x4 pw0, pw1, pq0, pq1, pk0, pk1, pa, pu; float pb; };
    Pre PA, PB; PA.pb = 0.f; PB.pb = 0.f;
    const int li = tid >> 3, lc = (tid & 7) * 8;
    auto issue = [&](int n, Pre& P) {
        const int cn = dir ? 127 - n : n, uidx = (sq * 4 + h) * 128 + cn; const size_t row = (size_t)sq * SEQ + cn * 64 + (dir ? 63 - li : li);
        const bf16* wp = Wg + row * 512 + h * 128 + lc; P.pw0 = *(const u32x4*)wp; P.pw1 = *(const u32x4*)(wp + 64);
        const bf16* qp = Qg + row * 512 + h * 128 + lc; P.pq0 = *(const u32x4*)qp; P.pq1 = *(const u32x4*)(qp + 64);
        const bf16* kp = KTg + ((size_t)uidx * 128 + (tid >> 2)) * 64 + (tid & 3) * 16; P.pk0 = *(const u32x4*)kp; P.pk1 = *(const u32x4*)(kp + 8);
        P.pa = *(const u32x4*)(ATg + ((size_t)uidx * 64 + li) * 64 + lc);
        P.pu = *(const u32x4*)(Ug + (((size_t)uidx * 128 + vs * 64 + li) * 64 + lc));
        if (tid < 64) P.pb = GBg[(size_t)uidx * 64 + tid];
    };
    auto commit = [&](const Pre& P) {
        *(u32x4*)(Wc + li * 136 + lc) = P.pw0; *(u32x4*)(Wc + li * 136 + 64 + lc) = P.pw1; *(u32x4*)(Qc + li * 136 + lc) = P.pq0; *(u32x4*)(Qc + li * 136 + 64 + lc) = P.pq1;
        *(u32x4*)(KTc + (tid >> 2) * 72 + (tid & 3) * 16) = P.pk0; *(u32x4*)(KTc + (tid >> 2) * 72 + (tid & 3) * 16 + 8) = P.pk1;
        *(u32x4*)(ATTc + li * 72 + lc) = P.pa; *(u32x4*)(Uc + li * 72 + lc) = P.pu;
        if (tid < 64) { const float pb = P.pb; bv[tid] = pb; ebv[tid] = __expf(pb); const float b63 = __shfl(pb, 63); e2[tid] = __expf(b63 - pb); }
    };
    float z0 = 0.f; asm volatile("" : "+v"(z0));
    ck::f32x16 S0 = ck::zero16(), S1 = ck::zero16();
    const int sel = wv >> 2, ti = (wv >> 1) & 1, tv = wv & 1, td = wv & 3;
    __syncthreads();
    for (int i = tid; i < 64 * 136 / 2; i += NTHREADS) ((unsigned*)ST)[i] = 0u;
    issue(0, PA); issue(1, PB); commit(PA);
    __syncthreads();
#pragma unroll 2
    for (int n = 0; n < 128; ++n) {
        if (n + 2 < 128) { if (n & 1) issue(n + 2, PB); else issue(n + 2, PA); }
        ck::f32x16 acc = ck::zero16();
        ck::mma<8>(acc, (sel ? Qc : Wc) + (32 * ti + r32) * 136 + 8 * hi, ST + (32 * tv + r32) * 136 + 8 * hi);
        if (sel == 0) {
#pragma unroll
            for (int g = 0; g < 4; ++g) { float vn[4], v2[4];
                const int ip0 = 32 * ti + 8 * g + 4 * hi; const u32x2 uu = *(const u32x2*)(Uc + (32 * tv + r32) * 72 + ip0); const f32x4 ee = *(const f32x4*)(e2 + ip0);
                vn[0] = bflo(uu.x) - acc[4 * g]; vn[1] = bfhi(uu.x) - acc[4 * g + 1]; vn[2] = bflo(uu.y) - acc[4 * g + 2]; vn[3] = bfhi(uu.y) - acc[4 * g + 3];
                v2[0] = vn[0] * ee.x; v2[1] = vn[1] * ee.y; v2[2] = vn[2] * ee.z; v2[3] = vn[3] * ee.w;
                u32x2 w; w.x = cvtpk(vn[0], vn[1]); w.y = cvtpk(vn[2], vn[3]); *(u32x2*)(VNT + (32 * tv + r32) * 72 + ip0) = w;
                u32x2 w2; if (dir) { w2.x = cvtpk(v2[3], v2[2]); w2.y = cvtpk(v2[1], v2[0]); *(u32x2*)(VN2T + (32 * tv + r32) * 72 + 60 - ip0) = w2; }
                else { w2.x = cvtpk(v2[0], v2[1]); w2.y = cvtpk(v2[2], v2[3]); *(u32x2*)(VN2T + (32 * tv + r32) * 72 + ip0) = w2; } } }
        __syncthreads();
        if (sel == 1) { ck::f32x16 a2 = ck::zero16(); ck::mma<4>(a2, ATTc + (32 * ti + r32) * 72 + 8 * hi, VNT + (32 * tv + r32) * 72 + 8 * hi);
            const int cn = dir ? 127 - n : n;
#pragma unroll
            for (int idx = 0; idx < 16; ++idx) { const int ip = 32 * ti + ck::crow(idx, hi); const size_t row = (size_t)sq * SEQ + cn * 64 + (dir ? 63 - ip : ip);
                og[row * 512 + 32 * tv + r32] = f2bf(ebv[ip] * acc[idx] + a2[idx]); } }
        if (sel == 0) { const float dec = ebv[63];
#pragma unroll
            for (int idx = 0; idx < 16; ++idx) { S0[idx] *= dec; S1[idx] *= dec; }
#pragma unroll
            for (int s = 0; s < 4; ++s) { const ck::bf16x8 ka = *(const ck::bf16x8*)(KTc + (32 * td + r32) * 72 + 8 * hi + 16 * s);
                S0 = __builtin_amdgcn_mfma_f32_32x32x16_bf16(ka, *(const ck::bf16x8*)(VN2T + r32 * 72 + 8 * hi + 16 * s), S0, 0, 0, 0);
                S1 = __builtin_amdgcn_mfma_f32_32x32x16_bf16(ka, *(const ck::bf16x8*)(VN2T + (32 + r32) * 72 + 8 * hi + 16 * s), S1, 0, 0, 0); }
#pragma unroll
            for (int g = 0; g < 4; ++g) { u32x2 w; w.x = cvtpk(S0[4 * g] + z0, S0[4 * g + 1] + z0); w.y = cvtpk(S0[4 * g + 2] + z0, S0[4 * g + 3] + z0); *(u32x2*)(ST + r32 * 136 + 32 * td + 8 * g + 4 * hi) = w;
                u32x2 w1; w1.x = cvtpk(S1[4 * g] + z0, S1[4 * g + 1] + z0); w1.y = cvtpk(S1[4 * g + 2] + z0, S1[4 * g + 3] + z0); *(u32x2*)(ST + (32 + r32) * 136 + 32 * td + 8 * g + 4 * hi) = w1; } }
        __syncthreads();
        if (n + 1 < 128) { if (n & 1) commit(PA); else commit(PB); }
        __syncthreads();
    }
}

__device__ __forceinline__ void gla_prep_setup(Ctx& C, int l) {
    float* up2 = (float*)(C.lds + 116224);
    __syncthreads();
    for (int i = C.tid; i < 2 * 2176; i += NTHREADS) { const int hs = i / 2176, r = i % 2176, h = (((C.wg >> 7) & 3) + 2 * hs) & 3;
        up2[i] = (r < 2048) ? C.in[IN_GLA_UP][((size_t)(l * 2 + (r >> 10)) * 16 + ((r >> 6) & 15)) * 256 + h * 64 + (r & 63)]
                            : C.in[IN_GLA_BIAS][(l * 2 + ((r - 2048) >> 6)) * 256 + h * 64 + (r & 63)]; }
    __syncthreads();
}
__device__ __forceinline__ void gla_prep_unit(Ctx& C, int uidx, int l, int hb) {
    const int cn = uidx & 127, h = (uidx >> 7) & 3, sq = uidx >> 9;
    int tid_ = threadIdx.x; asm volatile("" : "+v"(tid_));
    const int tid = tid_, dir = tid >> 8, t = tid & 255, lane = tid & 63, wv = __builtin_amdgcn_readfirstlane(tid >> 6), r32 = lane & 31, hi = lane >> 5;
    float* gB = (float*)C.lds + 2176; float* tot = gB + 8192;
    const int hs = ((h - (C.wg >> 7)) & 3) >> 1; const float* up = (const float*)(C.lds + 116224) + hs * 2176; const float* bs = up + 2048;
    bf16* Qr = (bf16*)(tot + 512); bf16* Kr = Qr + 64 * 72; bf16* Vr = Kr + 64 * 72; bf16* QD = Vr + 64 * 136; bf16* KD = QD + 2 * 64 * 72;
    const bf16* proj = (const bf16*)(C.ws + WS_PROJ) + (size_t)sq * SEQ * LDP;
    unsigned char* hfree = C.ws + WS_H + (size_t)hb * HBR * DM * 2;
    bf16* AMg = (bf16*)(C.ws + WS_GAM); bf16* KETg = (bf16*)(C.ws + WS_GKET); bf16* QEg = (bf16*)hfree; bf16* VTg = (bf16*)(hfree + 16 * MiB); float* DECg = (float*)(C.ws + WS_GDEC);
    __syncthreads();
    { const int lr = tid >> 3, lc = (tid & 7) * 8, vc = (tid & 7) * 16; const bf16* p = proj + (size_t)(cn * 64 + lr) * LDP;
        *(u32x4*)(Qr + lr * 72 + lc) = *(const u32x4*)(p + C_GQ + h * 64 + lc); *(u32x4*)(Kr + lr * 72 + lc) = *(const u32x4*)(p + C_GK + h * 64 + lc);
        *(u32x4*)(Vr + lr * 136 + vc) = *(const u32x4*)(p + C_GV + h * 128 + vc); *(u32x4*)(Vr + lr * 136 + vc + 8) = *(const u32x4*)(p + C_GV + h * 128 + vc + 8); }
    __syncthreads();
    { const int lr = t >> 2, lc = (t & 3) * 16, row = cn * 64 + (dir ? 63 - lr : lr); const bf16* p = proj + (size_t)row * LDP + (dir ? C_GWB : C_GWF);
        float g[16]; unpack8(*(const u32x4*)p, g); unpack8(*(const u32x4*)(p + 8), g + 8);
        const float* upd = up + dir * 1024;
#pragma unroll
        for (int i = 0; i < 16; ++i) { float z = bs[dir * 64 + lc + i];
#pragma unroll
            for (int r = 0; r < 16; ++r) z += g[r] * upd[r * 64 + lc + i];
            gB[(dir * 64 + lr) * 64 + lc + i] = ((z < 0.f ? z : 0.f) - __logf(1.0f + __expf(-fabsf(z)))) * 0.0625f; } }
    __syncthreads();
    { const int d = t & 63, seg = t >> 6; float s = 0.f;
#pragma unroll
        for (int q = 0; q < 16; ++q) { float* e = gB + (dir * 64 + seg * 16 + q) * 64 + d; s += *e; *e = s; }
        tot[(dir * 4 + seg) * 64 + d] = s; }
    __syncthreads();
    { const int lr = t >> 2, lc = (t & 3) * 16, seg = lr >> 4;
#pragma unroll
        for (int q4 = 0; q4 < 4; ++q4) { float* e = gB + (dir * 64 + lr) * 64 + lc + 4 * q4; f32x4 v = *(const f32x4*)e;
            for (int s = 0; s < seg; ++s) { const f32x4 tt = *(const f32x4*)(tot + (dir * 4 + s) * 64 + lc + 4 * q4); v += tt; }
            *(f32x4*)e = v; } }
    __syncthreads();
    { const int v = tid & 127, jb = tid >> 7; float x[16];
#pragma unroll
        for (int jj = 0; jj < 16; ++jj) x[jj] = bf2f(Vr[(jb * 16 + jj) * 136 + v]);
        bf16* o = VTg + ((size_t)uidx * 128 + v) * 64 + jb * 16; *(u32x4*)o = pack8(x); *(u32x4*)(o + 8) = pack8(x + 8); }
    if (t < 64) DECg[((size_t)dir * 1024 + uidx) * 64 + t] = __expf(gB[(dir * 64 + 63) * 64 + t]);
    { const int d = t & 63, jb = t >> 6; const float blast = gB[(dir * 64 + 63) * 64 + d]; float x[16];
#pragma unroll
        for (int jj = 0; jj < 16; ++jj) { const int jp = jb * 16 + jj, js = dir ? 63 - jp : jp; x[dir ? 15 - jj : jj] = bf2f(Kr[js * 72 + d]) * __expf(blast - gB[(dir * 64 + jp) * 64 + d]); }
        bf16* o = KETg + (((size_t)dir * 1024 + uidx) * 64 + d) * 64 + (dir ? 48 - jb * 16 : jb * 16); *(u32x4*)o = pack8(x); *(u32x4*)(o + 8) = pack8(x + 8); }
    { const int lr = t >> 2, lc = (t & 3) * 16, is = dir ? 63 - lr : lr; float xq[16], xk[16], qd[16], kd[16], qe[16];
        unpack8(*(const u32x4*)(Qr + is * 72 + lc), xq); unpack8(*(const u32x4*)(Qr + is * 72 + lc + 8), xq + 8); unpack8(*(const u32x4*)(Kr + is * 72 + lc), xk); unpack8(*(const u32x4*)(Kr + is * 72 + lc + 8), xk + 8);
#pragma unroll
        for (int i = 0; i < 16; ++i) { const float b = gB[(dir * 64 + lr) * 64 + lc + i], bmid = gB[(dir * 64 + 31) * 64 + lc + i];
            qd[i] = xq[i] * 0.125f * __expf(b - bmid); kd[i] = xk[i] * __expf(bmid - b); qe[i] = xq[i] * 0.125f * __expf(b); }
        bf16* qdp = QD + (dir * 64 + lr) * 72 + lc; *(u32x4*)qdp = pack8(qd); *(u32x4*)(qdp + 8) = pack8(qd + 8);
        bf16* kdp = KD + (dir * 64 + lr) * 72 + lc; *(u32x4*)kdp = pack8(kd); *(u32x4*)(kdp + 8) = pack8(kd + 8);
        bf16* o = QEg + (((size_t)dir * 1024 + uidx) * 64 + lr) * 64 + lc; *(u32x4*)o = pack8(qe); *(u32x4*)(o + 8) = pack8(qe + 8); }
    __syncthreads();
    { const int dw = wv >> 2, ti = (wv >> 1) & 1, tj = wv & 1; ck::f32x16 acc = ck::zero16();
        ck::mma<4>(acc, KD + (dw * 64 + 32 * tj + r32) * 72 + 8 * hi, QD + (dw * 64 + 32 * ti + r32) * 72 + 8 * hi);
        const int ip = 32 * ti + r32; bf16* o = AMg + (((size_t)dw * 1024 + uidx) * 64 + ip) * 64;
#pragma unroll
        for (int g = 0; g < 4; ++g) { const int j0 = 32 * tj + 8 * g + 4 * hi; float a[4];
#pragma unroll
            for (int q = 0; q < 4; ++q) a[q] = (j0 + q <= ip) ? acc[4 * g + q] : 0.f;
            u32x2 w; if (dw) { w.x = cvtpk(a[3], a[2]); w.y = cvtpk(a[1], a[0]); *(u32x2*)(o + 60 - j0) = w; } else { w.x = cvtpk(a[0], a[1]); w.y = cvtpk(a[2], a[3]); *(u32x2*)(o + j0) = w; } } }
}

__device__ __forceinline__ void gla_chunk_unit(Ctx& C, int unit, int l, int hb) {
    const int dir = unit & 1, h = (unit >> 1) & 3, sq = unit >> 3;
    int tid_ = threadIdx.x; asm volatile("" : "+v"(tid_));
    const int tid = tid_, lane = tid & 63, wv = __builtin_amdgcn_readfirstlane(tid >> 6), r32 = lane & 31, hi = lane >> 5;
    float* dl = (float*)C.lds;
    bf16* QE = (bf16*)(dl + 64); bf16* KET = QE + 64 * 72; bf16* VT = KET + 64 * 72; bf16* AM = VT + 128 * 72;
    bf16* ST0 = AM + 64 * 72;
    unsigned char* hfree = C.ws + WS_H + (size_t)hb * HBR * DM * 2;
    const bf16* AMg = (const bf16*)(C.ws + WS_GAM) + (size_t)dir * 1024 * 4096; const bf16* KETg = (const bf16*)(C.ws + WS_GKET) + (size_t)dir * 1024 * 4096;
    const bf16* QEg = (const bf16*)hfree + (size_t)dir * 1024 * 4096; const bf16* VTg = (const bf16*)(hfree + 16 * MiB); const float* DECg = (const float*)(C.ws + WS_GDEC) + (size_t)dir * 1024 * 64;
    bf16* og = (bf16*)(C.ws + WS_OGLA) + ((size_t)dir * HBR + (size_t)sq * SEQ) * 512 + h * 128;
    __syncthreads();
    for (int i = tid; i < 128 * 72 / 2; i += NTHREADS) ((unsigned*)ST0)[i] = 0u;
    const int lr = tid >> 3, lc = (tid & 7) * 8;
    u32x4 rqe, rke, ram, rv0, rv1; float rd = 0.f;
    auto issue = [&](int n) {
        const int cn = dir ? 127 - n : n; const size_t ub = (size_t)((sq * 4 + h) * 128 + cn);
        rqe = *(const u32x4*)(QEg + (ub * 64 + lr) * 64 + lc); rke = *(const u32x4*)(KETg + (ub * 64 + lr) * 64 + lc); ram = *(const u32x4*)(AMg + (ub * 64 + lr) * 64 + lc);
        rv0 = *(const u32x4*)(VTg + (ub * 128 + lr) * 64 + lc); rv1 = *(const u32x4*)(VTg + (ub * 128 + 64 + lr) * 64 + lc);
        if (tid < 64) rd = DECg[ub * 64 + tid];
    };
    float z0 = 0.f; asm volatile("" : "+v"(z0));
    ck::f32x16 S = ck::zero16();
    const int t2 = wv >> 2, tv = wv & 3;
    issue(0);
    for (int n = 0; n < 128; ++n) {
        *(u32x4*)(QE + lr * 72 + lc) = rqe; *(u32x4*)(KET + lr * 72 + lc) = rke; *(u32x4*)(AM + lr * 72 + lc) = ram; *(u32x4*)(VT + lr * 72 + lc) = rv0; *(u32x4*)(VT + (64 + lr) * 72 + lc) = rv1;
        if (tid < 64) dl[tid] = rd;
        __syncthreads();
        if (n + 1 < 128) issue(n + 1);
        const bf16* STc = ST0 + (n & 1) * 128 * 72; bf16* STn = ST0 + ((n + 1) & 1) * 128 * 72;
        { ck::f32x16 o = ck::zero16();
            ck::mma<4>(o, AM + (32 * t2 + r32) * 72 + 8 * hi, VT + (32 * tv + r32) * 72 + 8 * hi);
            ck::mma<4>(o, QE + (32 * t2 + r32) * 72 + 8 * hi, STc + (32 * tv + r32) * 72 + 8 * hi);
            const int cn = dir ? 127 - n : n;
#pragma unroll
            for (int idx = 0; idx < 16; ++idx) { const int ip = 32 * t2 + ck::crow(idx, hi); const size_t row = (size_t)cn * 64 + (dir ? 63 - ip : ip);
                og[row * 512 + 32 * tv + r32] = f2bf(o[idx] + z0); } }
        {
#pragma unroll
            for (int idx = 0; idx < 16; ++idx) S[idx] *= dl[32 * t2 + ck::crow(idx, hi)];
            ck::mma<4>(S, KET + (32 * t2 + r32) * 72 + 8 * hi, VT + (32 * tv + r32) * 72 + 8 * hi);
#pragma unroll
            for (int g = 0; g < 4; ++g) { u32x2 w; w.x = cvtpk(S[4 * g] + z0, S[4 * g + 1] + z0); w.y = cvtpk(S[4 * g + 2] + z0, S[4 * g + 3] + z0); *(u32x2*)(STn + (32 * tv + r32) * 72 + 32 * t2 + 8 * g + 4 * hi) = w; } }
        __syncthreads();
    }
}

__device__ __forceinline__ void phase_finalize2(Ctx& C, int l) {
    const bf16* proj = (const bf16*)(C.ws + WS_PROJ); bf16* ys = (bf16*)(C.ws + WS_YS);
    const int tpw = HBR / (C.G * NWAVES), gw = C.wg * NWAVES + C.wave, lane = C.lane, c0 = lane * 8;
    for (int tk = 0; tk < tpw; ++tk) { const int r = gw * tpw + tk;
#pragma unroll
        for (int br = 0; br < 2; ++br) {
            const bf16* of = (const bf16*)(C.ws + (br == 0 ? WS_OGLA : WS_OGDN)) + (size_t)r * 512 + c0; const bf16* ob = of + (size_t)HBR * 512;
            const float* nw = C.in[br == 0 ? IN_GLA_NORM : IN_GDN_NORM] + l * 128 + (c0 & 127);
            float a[8], b[8], o[8]; unpack8(*(const u32x4*)of, a); unpack8(*(const u32x4*)ob, b);
            float ss = 0.f;
#pragma unroll
            for (int i = 0; i < 8; ++i) { o[i] = a[i] + b[i]; ss += o[i] * o[i]; }
            const float rs = rsqrtf(grp16_sum(ss) * (1.0f / 128.0f) + EPS);
            const u32x4 gw_ = *(const u32x4*)(proj + (size_t)r * LDP + (br == 0 ? C_GR : C_NZ) + c0); float gz[8]; unpack8(gw_, gz);
            float yv[8];
#pragma unroll
            for (int i = 0; i < 8; ++i) yv[i] = o[i] * rs * nw[i] * siluf_(gz[i]);
            *(u32x4*)(ys + ((size_t)(br == 0 ? 0 : 2) * HBR + r) * 512 + c0) = pack8(yv);
        }
    }
}

namespace att {
using bf16x8 = __attribute__((ext_vector_type(8))) short;
using s16x4  = __attribute__((ext_vector_type(4))) short;
using f32x16 = __attribute__((ext_vector_type(16))) float;
constexpr int KVBLK = 64;
constexpr float SCALE = 0.125f, THR = 8.f;
constexpr int SHM_V = KVBLK * 128 * 2, SHM_K = KVBLK * 128 * 2;
#define KSWZ(row, colB) ((row) * 256 + ((colB) ^ (((row) & 7) << 4)))
#define SBAR() __builtin_amdgcn_sched_barrier(0)
__device__ __forceinline__ int crow(int r, int hi) { return (r & 3) + 8 * (r >> 2) + 4 * hi; }
__device__ __forceinline__ void partialSM(f32x16& p0, f32x16& p1, float& m_reg, float& mn, float& alpha) {
  constexpr float Cc = SCALE * 1.4426950408889634f;
  float pmax = p0[0]; for (int r = 1; r < 16; ++r) pmax = fmaxf(pmax, p0[r]); for (int r = 0; r < 16; ++r) pmax = fmaxf(pmax, p1[r]);
  { auto rr = __builtin_amdgcn_permlane32_swap(__float_as_uint(pmax), __float_as_uint(pmax), false, false);
    pmax = fmaxf(__uint_as_float(rr[0]), __uint_as_float(rr[1])); }
  if (__builtin_expect(__all(pmax - m_reg <= THR / SCALE), 1)) { mn = m_reg; alpha = 1.f; }
  else { mn = fmaxf(m_reg, pmax); alpha = __builtin_amdgcn_exp2f((m_reg - mn) * Cc); m_reg = mn; }
  float mnC = -mn * Cc;
  for (int r = 0; r < 16; ++r) p0[r] = fmaf(p0[r], Cc, mnC); for (int r = 0; r < 16; ++r) p1[r] = fmaf(p1[r], Cc, mnC);
  for (int r = 0; r < 16; ++r) p0[r] = __builtin_amdgcn_exp2f(p0[r]);
}
__device__ __forceinline__ void finishSM(f32x16& p0, f32x16& p1, float alpha, float& l_reg, bf16x8& pa0, bf16x8& pa1, bf16x8& pa2, bf16x8& pa3) {
  for (int r = 0; r < 16; ++r) p1[r] = __builtin_amdgcn_exp2f(p1[r]);
  float psa = 0, psb = 0, psc = 0, psd = 0;
  for (int r = 0; r < 8; ++r) { psa += p0[r]; psb += p0[8 + r]; } for (int r = 0; r < 8; ++r) { psc += p1[r]; psd += p1[8 + r]; }
  float ps = (psa + psb) + (psc + psd);
  { auto rr = __builtin_amdgcn_permlane32_swap(__float_as_uint(ps), __float_as_uint(ps), false, false);
    ps = __uint_as_float(rr[0]) + __uint_as_float(rr[1]); }
  l_reg = l_reg * alpha + ps;
#define PK4(P, BASE, OUT) do { unsigned a0 = cvtpk(P[BASE + 0], P[BASE + 1]), a1 = cvtpk(P[BASE + 2], P[BASE + 3]);   \
    unsigned b0 = cvtpk(P[BASE + 4], P[BASE + 5]), b1 = cvtpk(P[BASE + 6], P[BASE + 7]);                              \
    auto r0 = __builtin_amdgcn_permlane32_swap(a0, b0, false, false); auto r1 = __builtin_amdgcn_permlane32_swap(a1, b1, false, false); \
    u32x4 w = {r0[0], r1[0], r0[1], r1[1]}; OUT = *reinterpret_cast<bf16x8*>(&w); } while (0)
  PK4(p0, 0, pa0); PK4(p0, 8, pa1); PK4(p1, 0, pa2); PK4(p1, 8, pa3);
#undef PK4
}
__device__ __forceinline__ void qkt(f32x16& p0, f32x16& p1, const char* Ks, const bf16x8* qr, int r32, int hi, int s) {
  p0 = f32x16{}; p1 = f32x16{};
#pragma unroll
  for (int d0 = 0; d0 < 4; ++d0) { int cb = ((4 * s + d0) * 16 + hi * 8) * 2;
    bf16x8 b0 = *reinterpret_cast<const bf16x8*>(Ks + KSWZ(r32, cb));
    bf16x8 b1 = *reinterpret_cast<const bf16x8*>(Ks + KSWZ(32 + r32, cb));
    p0 = __builtin_amdgcn_mfma_f32_32x32x16_bf16(b0, qr[d0], p0, 0, 0, 0);
    p1 = __builtin_amdgcn_mfma_f32_32x32x16_bf16(b1, qr[d0], p1, 0, 0, 0); }
}
__device__ __forceinline__ int v_st(int k, int c) { const int kk = (k & ~0xC) | ((k & 4) << 1) | ((k & 8) >> 1); return ((kk >> 3) * 4 + (c >> 5)) * 512 + ((kk & 7) * 32 + (c & 31)) * 2; }
__device__ __forceinline__ int v_rd_base(int lane) { return ((lane & 3) << 3) | (((lane >> 2) & 3) << 6) | (((lane >> 4) & 1) << 5) | (((lane >> 5) & 1) << 8); }
constexpr int v_rd_off(int d0, int ks, int half) { return d0 * 512 + ks * 4096 + half * 2048; }
template <int OFF> __device__ __forceinline__ s16x4 tr_read(int vb) {
  s16x4 r; asm volatile("ds_read_b64_tr_b16 %0, %1 offset:%2" : "=&v"(r) : "v"(vb), "i"(OFF) : "memory"); return r;
}
template <int D0> __device__ __forceinline__ void pv_one(f32x16& od, int vb, bf16x8 pa0, bf16x8 pa1, bf16x8 pa2, bf16x8 pa3) {
  const s16x4 l0 = tr_read<v_rd_off(D0, 0, 0)>(vb), h0 = tr_read<v_rd_off(D0, 0, 1)>(vb), l1 = tr_read<v_rd_off(D0, 1, 0)>(vb), h1 = tr_read<v_rd_off(D0, 1, 1)>(vb);
  const s16x4 l2 = tr_read<v_rd_off(D0, 2, 0)>(vb), h2 = tr_read<v_rd_off(D0, 2, 1)>(vb), l3 = tr_read<v_rd_off(D0, 3, 0)>(vb), h3 = tr_read<v_rd_off(D0, 3, 1)>(vb);
  asm volatile("s_waitcnt lgkmcnt(0)" ::: "memory"); SBAR();
#define PK(Lo, Hi) (bf16x8){Lo[0], Lo[1], Lo[2], Lo[3], Hi[0], Hi[1], Hi[2], Hi[3]}
  od = __builtin_amdgcn_mfma_f32_32x32x16_bf16(pa0, PK(l0, h0), od, 0, 0, 0);
  od = __builtin_amdgcn_mfma_f32_32x32x16_bf16(pa1, PK(l1, h1), od, 0, 0, 0);
  od = __builtin_amdgcn_mfma_f32_32x32x16_bf16(pa2, PK(l2, h2), od, 0, 0, 0);
  od = __builtin_amdgcn_mfma_f32_32x32x16_bf16(pa3, PK(l3, h3), od, 0, 0, 0);
#undef PK
}
__device__ __forceinline__ void pv_d0(f32x16* o, int vb, bf16x8 pa0, bf16x8 pa1, bf16x8 pa2, bf16x8 pa3) {
  pv_one<0>(o[0], vb, pa0, pa1, pa2, pa3); pv_one<1>(o[1], vb, pa0, pa1, pa2, pa3); pv_one<2>(o[2], vb, pa0, pa1, pa2, pa3); pv_one<3>(o[3], vb, pa0, pa1, pa2, pa3);
}

__device__ __forceinline__ void attn_unit(const bf16* __restrict__ Qb, const bf16* __restrict__ Kh, const bf16* __restrict__ Vh, bf16* __restrict__ Yb,
                                          float lam, const float* gl, char* lds) {
  int tid_ = threadIdx.x; asm volatile("" : "+v"(tid_));
  const int tid = tid_, wid = __builtin_amdgcn_readfirstlane(tid >> 6), lane = tid & 63, r32 = lane & 31, hi = lane >> 5, s = wid >> 2, wq = wid & 3;
  char* V_lds = lds; char* K_lds = lds + 2 * SHM_V;
  float* ws = (float*)(lds + 2 * SHM_V + 2 * SHM_K) + wid * 64; float* li_l = ws; float* al_l = ws + 32;
  float m_reg = -1e30f, l_reg = 0; f32x16 o[4] = {}; bf16x8 qr[4];
  const bf16* Qw = Qb + (long)(wq * 32 + r32) * LDP + s * 64 + hi * 8;
#pragma unroll
  for (int d0 = 0; d0 < 4; ++d0) qr[d0] = *reinterpret_cast<const bf16x8*>(Qw + d0 * 16);
  const int sr = tid >> 4, sc = (tid & 15) * 8, vst0 = v_st(sr, sc), vst1 = v_st(32 + sr, sc);
  const int vb0 = (int)(uintptr_t)V_lds + v_rd_base(lane);
  struct { bf16x8 vs0, vs1, ks0, ks1; } sr_[2];
#define SLOAD(i, k0) do { sr_[i].vs0 = *reinterpret_cast<const bf16x8*>(&Vh[(long)((k0) + sr) * LDP + sc]); sr_[i].vs1 = *reinterpret_cast<const bf16x8*>(&Vh[(long)((k0) + 32 + sr) * LDP + sc]); \
    sr_[i].ks0 = *reinterpret_cast<const bf16x8*>(&Kh[(long)((k0) + sr) * LDP + sc]); sr_[i].ks1 = *reinterpret_cast<const bf16x8*>(&Kh[(long)((k0) + 32 + sr) * LDP + sc]); } while (0)
#define SWRITE(b, i) do { *(bf16x8*)(V_lds + (b) * SHM_V + vst0) = sr_[i].vs0;          \
    *(bf16x8*)(V_lds + (b) * SHM_V + vst1) = sr_[i].vs1; int kc = sc * 2;               \
    *(bf16x8*)(K_lds + (b) * SHM_K + KSWZ(sr, kc)) = sr_[i].ks0;                       \
    *(bf16x8*)(K_lds + (b) * SHM_K + KSWZ(32 + sr, kc)) = sr_[i].ks1; } while (0)
#define SWAIT() asm volatile("s_waitcnt vmcnt(4)" ::: "memory")
#define RESC(a) do { if (__any((a) < 1.f)) { if (hi == 0) al_l[r32] = (a); asm volatile("s_waitcnt lgkmcnt(0)" ::: "memory"); \
    for (int d = 0; d < 4; ++d) for (int r = 0; r < 16; ++r) o[d][r] *= al_l[crow(r, hi)]; } } while (0)
  f32x16 pA0, pA1, pB0, pB1; float mnA, mnB, alA, alB; bf16x8 pa0, pa1, pa2, pa3; const int NT = SEQ / KVBLK;
  constexpr int SE = 0, SO = 1;
  SLOAD(SE, 0); asm volatile("s_waitcnt vmcnt(0)" ::: "memory"); SWRITE(0, SE); __syncthreads();
  qkt(pA0, pA1, K_lds, qr, r32, hi, s); partialSM(pA0, pA1, m_reg, mnA, alA);
  SLOAD(SO, KVBLK); SLOAD(SE, 2 * KVBLK);
  SWAIT(); SWRITE(1, SO); __syncthreads();
  for (int j = 1; j + 1 < NT; j += 2) {
    SBAR(); qkt(pB0, pB1, K_lds + SHM_K, qr, r32, hi, s);
    finishSM(pA0, pA1, alA, l_reg, pa0, pa1, pa2, pa3); SBAR();
    SLOAD(SO, (j + 2) * KVBLK); SBAR();
    pv_d0(o, vb0, pa0, pa1, pa2, pa3); partialSM(pB0, pB1, m_reg, mnB, alB);
    __syncthreads(); SWAIT(); SWRITE(0, SE);
    RESC(alB); __syncthreads();
    SBAR(); qkt(pA0, pA1, K_lds, qr, r32, hi, s);
    finishSM(pB0, pB1, alB, l_reg, pa0, pa1, pa2, pa3); SBAR();
    if (j + 3 < NT) SLOAD(SE, (j + 3) * KVBLK); SBAR();
    pv_d0(o, vb0 + (int)SHM_V, pa0, pa1, pa2, pa3); partialSM(pA0, pA1, m_reg, mnA, alA);
    __syncthreads(); SWAIT(); SWRITE(1, SO);
    RESC(alA); __syncthreads();
  }
  SBAR(); qkt(pB0, pB1, K_lds + SHM_K, qr, r32, hi, s);
  finishSM(pA0, pA1, alA, l_reg, pa0, pa1, pa2, pa3); SBAR();
  pv_d0(o, vb0, pa0, pa1, pa2, pa3); partialSM(pB0, pB1, m_reg, mnB, alB);
  __syncthreads(); RESC(alB);
  finishSM(pB0, pB1, alB, l_reg, pa0, pa1, pa2, pa3); SBAR();
  pv_d0(o, vb0 + (int)SHM_V, pa0, pa1, pa2, pa3);
  if (hi == 0) li_l[r32] = l_reg; asm volatile("s_waitcnt lgkmcnt(0)" ::: "memory");
  float rli[16];
#pragma unroll
  for (int r = 0; r < 16; ++r) rli[r] = __builtin_amdgcn_rcpf(li_l[crow(r, hi)]);
  __syncthreads();
  int xb = (wq * 4096 + lane) * 4; asm volatile("" : "+v"(xb));
  float* X = (float*)(lds + xb);
  if (s == 1) {
#pragma unroll
    for (int d0 = 0; d0 < 4; ++d0)
#pragma unroll
      for (int r = 0; r < 16; ++r) X[(d0 * 16 + r) * 64] = o[d0][r] * rli[r];
  }
  __syncthreads();
  if (s == 0) {
    int yb = ((wq * 32 + 4 * hi) * 512 + r32) * 2; asm volatile("" : "+v"(yb));
    bf16* Yw = (bf16*)((char*)Yb + yb);
#pragma unroll
    for (int r = 0; r < 16; ++r) {
      float dv[4], t = 0.f;
#pragma unroll
      for (int d0 = 0; d0 < 4; ++d0) { dv[d0] = o[d0][r] * rli[r] - lam * X[(d0 * 16 + r) * 64]; t += dv[d0] * dv[d0]; }
      t = grp32_sum(t);
      const float rs = rsqrtf(t * (1.0f / 128.0f) + EPS);
#pragma unroll
      for (int d0 = 0; d0 < 4; ++d0) Yw[((r & 3) + 8 * (r >> 2)) * 512 + d0 * 32] = f2bf(dv[d0] * rs * gl[d0 * 32 + r32]);
    }
  }
  __syncthreads();
#undef SLOAD
#undef SWRITE
#undef SWAIT
#undef RESC
}
#undef KSWZ
#undef SBAR
}

__device__ __forceinline__ void attn_setup(Ctx& C, int l) {
  float* gl = (float*)(C.lds + 2 * att::SHM_V + 2 * att::SHM_K + NWAVES * 64 * 4);
  const float lam_init = 0.8f - 0.6f * __expf(-0.3f * (float)l);
  int t_ = threadIdx.x; asm volatile("" : "+v"(t_));
  __syncthreads();
  if (t_ < 128) gl[t_] = C.in[IN_DIFF_NORM][l * 128 + t_] * (1.0f - lam_init);
  if (t_ == 128) gl[128] = ((const float*)(C.ws + WS_MODF))[49152 + l];
  __syncthreads();
}
__device__ __forceinline__ void attn_run_unit(Ctx& C, int u) {
  float* gl = (float*)(C.lds + 2 * att::SHM_V + 2 * att::SHM_K + NWAVES * 64 * 4);
  const float lam = gl[128];
  const bf16* proj = (const bf16*)(C.ws + WS_PROJ); bf16* ys = (bf16*)(C.ws + WS_YS) + (size_t)HBR * 512;
  const int qb = u & 63, h = (u >> 6) & 3, sq = u >> 8;
  const bf16* seqp = proj + (size_t)sq * SEQ * LDP;
  att::attn_unit(seqp + (size_t)(qb * 128) * LDP + C_DQ + 2 * h * 64, seqp + C_DK + h * 128, seqp + C_DV + h * 128,
                 ys + ((size_t)sq * SEQ + qb * 128) * 512 + h * 128, lam, gl, (char*)C.lds);
}

__device__ __forceinline__ void phase_moe_prep(Ctx& C) {
    int* tot = (int*)(C.lds + 8 * 8704 + 4096); int* baseA = tot + 8; int* baseB = baseA + 8; int* off = baseB + 8;
    const int* gcnt = (const int*)(C.ws + WS_GCNT); const int* lpos = (const int*)(C.ws + WS_LPOS); const uint4* route = (const uint4*)(C.ws + WS_ROUTE);
    int* slotrow = (int*)(C.ws + WS_SLOTROW); int* tile_exp = (int*)(C.ws + WS_TILEEXP);
    const bf16* H = (const bf16*)(C.ws + WS_H); bf16* AS = (bf16*)(C.ws + WS_ASORT);
    __syncthreads();
    if (C.tid < 40) tot[C.tid] = 0;
    __syncthreads();
    { const int e = C.tid & 7, chunk = C.tid >> 3, gA = C.wg, gB = 256 + C.wg; int t = 0, a = 0, b = 0;
        for (int g = chunk * 8; g < chunk * 8 + 8; ++g) { const int c = gcnt[g * 8 + e]; t += c; if (g < gA) a += c; if (g < gB) b += c; }
        atomicAdd(&tot[e], t); atomicAdd(&baseA[e], a); atomicAdd(&baseB[e], b); }
    __syncthreads();
    if (C.tid == 0) { int o = 0; for (int e = 0; e < 8; ++e) { off[e] = o; o += (tot[e] + 255) & ~255; } off[8] = o; }
    __syncthreads();
    if (C.wg == 0 && C.tid < MOE_MAXT + 1) { if (C.tid == MOE_MAXT) tile_exp[MOE_MAXT] = off[8] >> 8;
        else { int e = 0; for (int q = 1; q < 8; ++q) if (C.tid * 256 >= off[q]) e = q; tile_exp[C.tid] = e; } }
    for (int hbi = 0; hbi < 2; ++hbi) { const int* base = hbi ? baseB : baseA;
        for (int i = C.wave; i < 64; i += NWAVES) { const int r = hbi * HBR + C.wg * 64 + i; const uint4 rt = route[r];
            const int row0 = off[rt.x] + base[rt.x] + lpos[2 * r], row1 = off[rt.y] + base[rt.y] + lpos[2 * r + 1];
            if (C.lane == 0) { slotrow[2 * r] = row0; slotrow[2 * r + 1] = row1; }
            const u32x4* src = (const u32x4*)(H + (size_t)r * DM) + C.lane; const u32x4 v0 = src[0], v1 = src[64];
            u32x4* d0 = (u32x4*)(AS + (size_t)row0 * DM) + C.lane; u32x4* d1 = (u32x4*)(AS + (size_t)row1 * DM) + C.lane;
            d0[0] = v0; d0[64] = v1; d1[0] = v0; d1[64] = v1; } }
    { const int gw = C.wg * NWAVES + C.wave;
        for (int e = 0; e < 8; ++e) { const int p0 = off[e] + tot[e], npad = off[e + 1] - p0;
            if (gw < npad) { u32x4* d = (u32x4*)(AS + (size_t)(p0 + gw) * DM) + C.lane; d[0] = (u32x4){0, 0, 0, 0}; d[64] = (u32x4){0, 0, 0, 0}; } } }
}

struct Args { const float* in[25]; float* out; unsigned char* ws; int ph_lo, ph_hi; };
constexpr int NPH = 41;

__global__ void __launch_bounds__(NTHREADS, 2) mk_fwd(Args args) {
    extern __shared__ __attribute__((aligned(16))) unsigned char lds[];
    Ctx C;
#pragma unroll
    for (int i = 0; i < 25; ++i) C.in[i] = args.in[i];
    C.out = args.out; C.ws = args.ws; C.lds = lds;
    C.tid = threadIdx.x; C.lane = C.tid & 63; C.wave = __builtin_amdgcn_readfirstlane(C.tid >> 6); C.wg = blockIdx.x; C.G = gridDim.x;
    LAS unsigned char* ldsl = (LAS unsigned char*)lds;
    volatile LAS unsigned* MISC = (volatile LAS unsigned*)(ldsl + MISC_OFF);
    if (C.tid < 64) MISC[C.tid] = 0u;
    __syncthreads();
    const int lo = args.ph_lo, hi = args.ph_hi;
    const bool multi = (hi - lo) > 1;
    XcdBarrier bar; bar.bar = (unsigned*)(C.ws + WS_CTL) + CW_BAR; bar.x = 0; bar.st = MISC + 8;
    if (multi) bar = xcd_barrier_post((unsigned*)(C.ws + WS_CTL) + CW_BAR, MISC + 8);
    int ph = 0;
#define ENTER() do { int t_ = threadIdx.x; asm volatile("" : "+v"(t_)); C.tid = t_; C.lane = t_ & 63; C.wave = __builtin_amdgcn_readfirstlane(t_ >> 6); } while (0)
#define RUN(k) ((k) >= lo && (k) < hi)
#define SEAM(k) do { if (RUN(k) && RUN((k) + 1)) xcd_barrier(bar); } while (0)

    bf16* H = (bf16*)(C.ws + WS_H); bf16* PROJ = (bf16*)(C.ws + WS_PROJ);

    if (RUN(ph)) { ENTER(); mod_partials(C); __syncthreads(); int base = 0; convert_mixer_weights(C, 0, base); convert_ffn_weights(C, base); }
    SEAM(ph); ++ph;
    if (RUN(ph)) { ENTER(); phase_norm_in(C, C.in[IN_X], 0); }
    SEAM(ph); ++ph;

    for (int l_ = 0; l_ < 2; ++l_) {
        int l = l_; asm volatile("" : "+s"(l));
        for (int hb_ = 0; hb_ < 2; ++hb_) {
            int hb = hb_; asm volatile("" : "+s"(hb));
            if (RUN(ph)) { ENTER(); pg8::Gemm g{H + (size_t)hb * HBR * DM, (const bf16*)(C.ws + WS_WIN), HBR, 8192, DM}; pg8::StaticOrder S; S.init(HBR, 8192, C.G, C.wg);
                pg8::EpiStoreBf16 E{PROJ, LDP, 0};
                pg8::gemm_phase<pg8::EpiStoreBf16, pg8::StaticOrder>(ldsl, g, S, E, nullptr);
                proj_tail_unit(C, hb); }
            SEAM(ph); ++ph;
            if (RUN(ph)) { ENTER(); gla_prep_setup(C, l); for (int u = C.wg; u < 1024; u += C.G) gla_prep_unit(C, u, l, hb); }
            SEAM(ph); ++ph;
            if (RUN(ph)) { ENTER();
                unsigned* qctr = (unsigned*)(C.ws + WS_CTL) + 1024 + 64 * (l * 2 + hb); unsigned* gdone = qctr + 16; unsigned* rdone = qctr + 32;
                bool gl_ok = false, pp_ok = false, g_ok = false, r_ok = false; unsigned pend = 0;
                for (;;) {
                    __syncthreads();
                    if (C.tid == 0) MISC[16] = atomicAdd(qctr, 1u);
                    __syncthreads();
                    const int item = (int)MISC[16];
                    if (pend && !(item >= 16 && item < 528)) {
                        asm volatile("s_waitcnt vmcnt(0)" ::: "memory"); __syncthreads();
                        if (C.tid == 0) { __builtin_amdgcn_fence(__ATOMIC_RELEASE, "agent"); asm volatile("s_waitcnt vmcnt(0)" ::: "memory"); (void)xb_add(gdone, pend); }
                        pend = 0; }
                    if (item >= 1328) break;
                    if (item < 16) { gla_chunk_unit(C, item, l, hb); gl_ok = false; pp_ok = false; }
                    else if (item < 528) { if (!pp_ok) { gdn_prep_setup(C, l); pp_ok = true; }
                        gdn_prep_unit(C, 2 * (item - 16), l); gdn_prep_unit(C, 2 * (item - 16) + 1, l); gl_ok = false;
                        ++pend; }
                    else if (item < 560) { if (!g_ok) { if (C.tid == 0) { XB_SPIN(xb_ld(gdone) < 512u, bar.bar); __builtin_amdgcn_fence(__ATOMIC_ACQUIRE, "agent"); asm volatile("s_waitcnt vmcnt(0)" ::: "memory"); }
                            __syncthreads(); g_ok = true; }
                        gdn_scan_unit(C, item - 528); gl_ok = false; pp_ok = false; }
                    else if (item < 816) { rope_item(C, hb, item - 560);
                        asm volatile("s_waitcnt vmcnt(0)" ::: "memory"); __syncthreads(); if (C.tid == 0) (void)xb_add(rdone, 1u); }
                    else { if (!r_ok) { if (C.tid == 0) { XB_SPIN(xb_ld(rdone) < 256u, bar.bar); __builtin_amdgcn_fence(__ATOMIC_ACQUIRE, "agent"); asm volatile("s_waitcnt vmcnt(0)" ::: "memory"); }
                            __syncthreads(); r_ok = true; }
                        if (!gl_ok) { attn_setup(C, l); gl_ok = true; } attn_run_unit(C, item - 816); }
                }
            }
            SEAM(ph); ++ph;
            if (RUN(ph)) { ENTER(); phase_finalize2(C, l); }
            SEAM(ph); ++ph;
            if (RUN(ph)) { ENTER(); pg8::Gemm g{(const bf16*)(C.ws + WS_YS), (const bf16*)(C.ws + WS_WB), 3 * HBR, 3 * DM, 512}; pg8::SchedMerge S{HBR / 256, C.G, C.wg};
                pg8::EpiMerge E{PROJ + C_MG, LDP, (bf16*)(C.ws + WS_MERGED), HBR / 256};
                pg8::gemm_phase<pg8::EpiMerge, pg8::SchedMerge>(ldsl, g, S, E, nullptr); }
            SEAM(ph); ++ph;
            if (RUN(ph)) { ENTER(); pg8::Gemm g{(const bf16*)(C.ws + WS_MERGED), (const bf16*)(C.ws + WS_WO), HBR, DM, DM}; pg8::StaticOrder S; S.init(HBR, DM, C.G, C.wg);
                pg8::EpiStoreBf16 E{(bf16*)(C.ws + WS_Y), DM, 0};
                pg8::gemm_phase<pg8::EpiStoreBf16, pg8::StaticOrder>(ldsl, g, S, E, nullptr); }
            SEAM(ph); ++ph;
            if (RUN(ph)) { ENTER(); phase_resnorm(C, hb * HBR, HBR, (l == 0) ? C.in[IN_X] : (const float*)C.out, (const float*)(C.ws + WS_Y), hb * HBR, false,
                                       l, 2, 1, true, l, 4, 3, 2, l == 1, hb * 256); }
            if (hb == 1) SEAM(ph);
            ++ph;
        }
        if (l == 0) {
            if (RUN(ph)) { ENTER(); pg8::Gemm g{H, (const bf16*)(C.ws + WS_W13), TOK, 2 * DFF, DM}; pg8::StaticOrder S; S.init(TOK, 2 * DFF, C.G, C.wg);
                pg8::EpiSwiGLU E{(bf16*)(C.ws + WS_HID), DFF, 0, 0};
                pg8::gemm_phase<pg8::EpiSwiGLU, pg8::StaticOrder>(ldsl, g, S, E, nullptr); }
            SEAM(ph); ++ph;
            if (RUN(ph)) { ENTER(); pg8::Gemm g{(const bf16*)(C.ws + WS_HID), (const bf16*)(C.ws + WS_W2), TOK, DM, DFF}; pg8::StaticOrder S; S.init(TOK, DM, C.G, C.wg);
                pg8::EpiStoreBf16 E{(bf16*)(C.ws + WS_Y2), DM, 0};
                pg8::gemm_phase<pg8::EpiStoreBf16, pg8::StaticOrder>(ldsl, g, S, E, nullptr); }
            SEAM(ph); ++ph;
            if (RUN(ph)) { ENTER(); phase_resnorm(C, 0, TOK, (const float*)C.out, (const float*)(C.ws + WS_Y2), 0, false, 0, 5, 3, true, 1, 1, 0, 0, false, 0);
                __syncthreads(); int base = 0; convert_mixer_weights(C, 1, base); }
            SEAM(ph); ++ph;
        } else {
            if (RUN(ph)) { ENTER(); phase_moe_prep(C); __syncthreads(); int base = 0; convert_moe_weights(C, base); }
            SEAM(ph); ++ph;
            const int* tile_exp = (const int*)(C.ws + WS_TILEEXP);
            for (int p_ = 0; p_ < MOE_NPASS; ++p_) {
                int p = p_; asm volatile("" : "+s"(p));
                if (RUN(ph)) { ENTER(); const int ntl = tile_exp[MOE_MAXT], t0 = p * MOE_PASS_T; int nt = ntl - t0; nt = nt < 0 ? 0 : (nt > MOE_PASS_T ? MOE_PASS_T : nt);
                    pg8::Gemm g{(const bf16*)(C.ws + WS_ASORT), (const bf16*)(C.ws + WS_MW13), 0, 0, DM}; pg8::SchedMoe1 S{tile_exp, t0, nt, C.G, C.wg};
                    pg8::EpiSwiGLU E{(bf16*)(C.ws + WS_MHID), DEXP, 1, t0};
                    pg8::gemm_phase<pg8::EpiSwiGLU, pg8::SchedMoe1>(ldsl, g, S, E, nullptr); }
                SEAM(ph); ++ph;
                if (RUN(ph)) { ENTER(); const int ntl = tile_exp[MOE_MAXT], t0 = p * MOE_PASS_T; int nt = ntl - t0; nt = nt < 0 ? 0 : (nt > MOE_PASS_T ? MOE_PASS_T : nt);
                    if (p < MOE_NPASS - 1) {
                    pg8::Gemm g{(const bf16*)(C.ws + WS_MHID), (const bf16*)(C.ws + WS_MW2), 0, 0, DEXP, 0}; pg8::SchedMoe2 S{tile_exp, t0, nt, C.G, C.wg};
                    pg8::EpiStoreBf16 E{(bf16*)(C.ws + WS_ASORT), DM, 1};
                    pg8::gemm_phase<pg8::EpiStoreBf16, pg8::SchedMoe2>(ldsl, g, S, E, nullptr);
                    } else {
                    pg8::Gemm g{(const bf16*)(C.ws + WS_MHID), (const bf16*)(C.ws + WS_MW2), 0, 0, DEXP / 4, DEXP}; pg8::SchedMoe2K S{tile_exp, t0, nt, C.G, C.wg};
                    pg8::EpiStoreBf16 E{(bf16*)(C.ws + WS_MPART), DM, 2};
                    pg8::gemm_phase<pg8::EpiStoreBf16, pg8::SchedMoe2K>(ldsl, g, S, E, nullptr); } }
                SEAM(ph); ++ph;
            }
            if (RUN(ph)) { ENTER(); phase_resnorm(C, 0, TOK, (const float*)C.out, nullptr, 0, true, 1, 5, 3, false, 1, 0, 0, 0, false, 0); }
            ++ph;
        }
    }
#undef RUN
#undef SEAM
}

extern "C" void kernel_launch(void* const* d_in, const int* in_sizes, int n_in, void* d_out, int out_size, void* d_ws, size_t ws_size, hipStream_t stream) {
    static int grid = 0;
    if (grid == 0) {
        if (n_in != 25 || out_size != TOK * DM || ws_size < WS_END) { fprintf(stderr, "kernel_launch: unexpected problem (n_in %d out %d ws %zu, need ws >= %zu)\n", n_in, out_size, ws_size, (size_t)WS_END); grid = -1; return; }
        int dev = 0, cus = 0, per_cu = 0;
        if (hipGetDevice(&dev) != hipSuccess || hipDeviceGetAttribute(&cus, hipDeviceAttributeMultiprocessorCount, dev) != hipSuccess) { grid = -1; return; }
        if (hipFuncSetAttribute((const void*)mk_fwd, hipFuncAttributeMaxDynamicSharedMemorySize, LDS_BYTES) != hipSuccess) { fprintf(stderr, "kernel_launch: hipFuncSetAttribute failed\n"); grid = -1; return; }
        if (hipOccupancyMaxActiveBlocksPerMultiprocessor(&per_cu, (const void*)mk_fwd, NTHREADS, LDS_BYTES) != hipSuccess || per_cu < 1) fprintf(stderr, "kernel_launch: occupancy query says %d\n", per_cu);
        (void)hipGetLastError();
        grid = cus;
        if (grid != 256) fprintf(stderr, "kernel_launch: %d CUs (built for 256)\n", grid);
    }
    if (grid < 0) return;
    (void)hipMemsetAsync((char*)d_ws + WS_CTL, 0, CTL_ZERO_BYTES, stream);
    Args a{};
    for (int i = 0; i < 25; ++i) a.in[i] = (const float*)d_in[i];
    a.out = (float*)d_out; a.ws = (unsigned char*)d_ws;
#if MK_ONE_LAUNCH
    a.ph_lo = 0; a.ph_hi = 1 << 20;
    hipLaunchKernelGGL(mk_fwd, dim3(grid), dim3(NTHREADS), LDS_BYTES, stream, a);
#else
    for (int p = 0; p < NPH; ++p) { a.ph_lo = p; a.ph_hi = p + 1; hipLaunchKernelGGL(mk_fwd, dim3(grid), dim3(NTHREADS), LDS_BYTES, stream, a); }
#endif
    const hipError_t le = hipPeekAtLastError();
    if (le != hipSuccess) fprintf(stderr, "kernel_launch: launch failed: %s\n", hipGetErrorName(le));
}
```

```cpp
#include <hip/hip_runtime.h>
#include <cstdio>
#include <cstdint>

#ifndef MK_ONE_LAUNCH
#define MK_ONE_LAUNCH 1
#endif

constexpr int DM = 1024, NBATCH = 4, SEQ = 8192, TOK = NBATCH * SEQ, HBR = 16384;
constexpr int INC = 8240, LDP = 8448;
constexpr int C_GQ = 0, C_GK = 256, C_GV = 512, C_GR = 1024, C_GWF = 1536, C_GWB = 1552, C_DQ = 1568, C_DK = 2080, C_DV = 2592,
              C_NQ = 3104, C_NK = 3616, C_NV = 4128, C_NZ = 4640, C_NBF = 5152, C_NBB = 5156, C_NAF = 5160, C_NAB = 5164, C_MG = 5168;
constexpr int DFF = 2816, NEXP = 8, DEXP = 3584;
constexpr float EPS = 1e-6f;
constexpr int NTHREADS = 512, NWAVES = 8;
constexpr int MOE_MAXT = 264, MOE_PASS_T = 128, MOE_NPASS = 3;

constexpr size_t MiB = 1u << 20;
constexpr size_t WS_CTL = 0, CTL_ZERO_BYTES = 1 * MiB;
constexpr size_t WS_MODP = 1 * MiB;
constexpr size_t WS_MODF = 2 * MiB + 512 * 1024;
constexpr size_t WS_ROUTE = 3 * MiB;
constexpr size_t WS_LPOS = 3 * MiB + 512 * 1024;
constexpr size_t WS_SLOTROW = 3 * MiB + 768 * 1024;
constexpr size_t WS_GCNT = 4 * MiB;
constexpr size_t WS_TILEEXP = 4 * MiB + 64 * 1024;
constexpr size_t WS_GATE = 5 * MiB;
constexpr size_t WS_GB = 5 * MiB;
constexpr size_t WS_WIN = 8 * MiB;
constexpr size_t WS_WB = WS_WIN + (size_t)LDP * DM * 2;
constexpr size_t WS_WO = WS_WB + 3u * 1024 * 512 * 2;
constexpr size_t WS_H = 32 * MiB;
constexpr size_t WS_PROJ = 96 * MiB;
constexpr size_t WS_QKVC = 360 * MiB;
constexpr size_t WS_QN = 360 * MiB;
constexpr size_t WS_GAM = 376 * MiB;
constexpr size_t WS_GKET = 392 * MiB;
constexpr size_t WS_GDEC = 5 * MiB + 512 * 1024;
constexpr size_t WS_OGLA = 408 * MiB;
constexpr size_t WS_OGDN = 440 * MiB;
constexpr size_t WS_U = 472 * MiB;
constexpr size_t WS_W = 504 * MiB;
constexpr size_t WS_YS = 536 * MiB;
constexpr size_t WS_ATT = WS_YS;
constexpr size_t WS_KT = WS_YS + 32 * MiB;
constexpr size_t WS_W13 = 584 * MiB;
constexpr size_t WS_W2 = WS_W13 + (size_t)2 * DFF * DM * 2;
constexpr size_t WS_MERGEDF = 360 * MiB;
constexpr size_t WS_MERGED = 424 * MiB;
constexpr size_t WS_Y = 472 * MiB;
constexpr size_t WS_HID = 96 * MiB;
constexpr size_t WS_Y2 = 272 * MiB;
constexpr size_t WS_MW13 = 96 * MiB;
constexpr size_t WS_MW2 = 208 * MiB;
constexpr size_t WS_ASORT = 264 * MiB;
constexpr size_t WS_MHID = 396 * MiB;
constexpr size_t WS_MPART = WS_H;
constexpr size_t WS_END = 620 * MiB;
static_assert(WS_W2 + (size_t)DM * DFF * 2 <= WS_END && WS_WO + 2u * MiB <= WS_H && WS_HID + (size_t)TOK * DFF * 2 <= WS_Y2 && WS_MHID + 224 * MiB <= WS_END, "ws map");
constexpr int CW_BAR = 4096;

constexpr int RING_BYTES = 131072;
constexpr int LDS_BYTES = 147456;
constexpr int MISC_OFF = LDS_BYTES - 256;

#define LAS __attribute__((address_space(3)))
typedef unsigned short bf16;
typedef float f32x4 __attribute__((ext_vector_type(4)));
typedef unsigned u32x4 __attribute__((ext_vector_type(4)));
typedef unsigned u32x2 __attribute__((ext_vector_type(2)));

typedef __bf16 bf16x2_t __attribute__((ext_vector_type(2)));
typedef float f32x2_t __attribute__((ext_vector_type(2)));
__device__ __forceinline__ unsigned cvtpk(float lo, float hi) { const f32x2_t v = {lo, hi}; const bf16x2_t b = __builtin_convertvector(v, bf16x2_t); return __builtin_bit_cast(unsigned, b); }
__device__ __forceinline__ float bflo(unsigned w) { return __uint_as_float(w << 16); }
__device__ __forceinline__ float bfhi(unsigned w) { return __uint_as_float(w & 0xffff0000u); }
__device__ __forceinline__ float bf2f(bf16 b) { return __uint_as_float(((unsigned)b) << 16); }
__device__ __forceinline__ bf16 f2bf(float f) { return (bf16)(cvtpk(f, 0.f) & 0xffffu); }
__device__ __forceinline__ void unpack8(const u32x4 w, float* x) { x[0] = bflo(w.x); x[1] = bfhi(w.x); x[2] = bflo(w.y); x[3] = bfhi(w.y); x[4] = bflo(w.z); x[5] = bfhi(w.z); x[6] = bflo(w.w); x[7] = bfhi(w.w); }
__device__ __forceinline__ u32x4 pack8(const float* x) { u32x4 w; w.x = cvtpk(x[0], x[1]); w.y = cvtpk(x[2], x[3]); w.z = cvtpk(x[4], x[5]); w.w = cvtpk(x[6], x[7]); return w; }
__device__ __forceinline__ float sigmoidf_(float x) { return __builtin_amdgcn_rcpf(1.0f + __expf(-x)); }
__device__ __forceinline__ float siluf_(float x) { return x * __builtin_amdgcn_rcpf(1.0f + __expf(-x)); }
#define DPP_ADD(v, ctrl) ((v) + __builtin_bit_cast(float, __builtin_amdgcn_update_dpp(0, __builtin_bit_cast(int, (v)), (ctrl), 0xF, 0xF, true)))
__device__ __forceinline__ float grp8_sum(float v) { v = DPP_ADD(v, 0xB1); v = DPP_ADD(v, 0x4E); v = DPP_ADD(v, 0x141); return v; }
__device__ __forceinline__ float grp16_sum(float v) { v = grp8_sum(v); v = DPP_ADD(v, 0x140); return v; }
__device__ __forceinline__ float grp32_sum(float v) { v = grp16_sum(v); v += __shfl_xor(v, 16); return v; }
__device__ __forceinline__ float wave_sum(float v) { v = grp32_sum(v);
    auto rr = __builtin_amdgcn_permlane32_swap(__float_as_uint(v), __float_as_uint(v), false, false); return __uint_as_float(rr[0]) + __uint_as_float(rr[1]); }

namespace pg8 {
#define PG8_LAS __attribute__((address_space(3)))
typedef unsigned short bf16_t;
typedef short bf16x8 __attribute__((ext_vector_type(8)));
typedef float f32x4 __attribute__((ext_vector_type(4)));
typedef unsigned u32x4 __attribute__((ext_vector_type(4)));
constexpr int BM = 256, BK = 64, HALF = 128, HTB = HALF * BK * 2  , STAGE_BYTES = 8 * HTB, NXCD = 8, WGM = 8;

__host__ __device__ __forceinline__ int lds_byte(int r, int c) { const int st = (r >> 4) * 2 + (c >> 5), rr = r & 15, cc = c & 31, ob = rr * 64 + cc * 2; return st * 1024 + (ob ^ (((ob >> 9) & 1) << 5)); }
__host__ __device__ __forceinline__ void stage_rc(int b, int& R, int& C) { const int st = b / 1024, sb = b % 1024, swz = sb ^ (((sb >> 9) & 1) << 5); R = (st >> 1) * 16 + swz / 64; C = (st & 1) * 32 + (swz % 64) / 2; }
__host__ __device__ __forceinline__ int perm32(int rho) { const int n = rho >> 4, i = rho & 15; return 8 * (i >> 2) + 4 * n + (i & 3); }

struct Unit { int pm, pn, aux, koff; };
struct Gemm { const bf16_t* A; const bf16_t* Bt; int M, N, K, ldk; };

struct StaticOrder {
    int nM, nN, nwg, G, c;
    __host__ __device__ void init(int M, int N, int G_, int c_) { nM = M / BM; nN = N / BM; nwg = nM * nN; G = G_; c = c_; }
    __host__ __device__ bool next(int i, Unit& u) const {
        const long L = (long)i * G + c; if (L >= nwg) return false;
        int wgid = (int)L; { const int q = nwg / NXCD, r = nwg % NXCD, xcd = wgid % NXCD, off = wgid / NXCD; wgid = (xcd < r ? xcd * (q + 1) : r * (q + 1) + (xcd - r) * q) + off; }
        const int nig = WGM * nN, gid = wgid / nig, fm = gid * WGM, gsz = (nM - fm) < WGM ? (nM - fm) : WGM;
        u.pm = fm + ((wgid % nig) % gsz); u.pn = (wgid % nig) / gsz; u.aux = 0; u.koff = 0; return true;
    }
    __device__ __forceinline__ void a_ready(const Unit&) const {}
    __device__ __forceinline__ void done(const Unit&) const {}
};
struct CountedOrder : StaticOrder {
    const unsigned* ready; unsigned need; unsigned* tmo;
    __device__ __forceinline__ void a_ready(const Unit& u) const {
        if (threadIdx.x < 64) {
            const unsigned long long t0 = __builtin_amdgcn_s_memrealtime(); unsigned polls = 0;
            while ((unsigned)__builtin_amdgcn_readfirstlane(__hip_atomic_load(ready + 64 * u.pm, __ATOMIC_RELAXED, __HIP_MEMORY_SCOPE_AGENT)) < need) {
                if ((++polls & 255u) == 0u && __builtin_amdgcn_readfirstlane(__hip_atomic_load(tmo, __ATOMIC_RELAXED, __HIP_MEMORY_SCOPE_AGENT)) != 0u) break;
                if (__builtin_amdgcn_s_memrealtime() - t0 > 2000000ull) {
                    if (threadIdx.x == 0) { unsigned expect = 0u; __hip_atomic_compare_exchange_strong(tmo + 1, &expect, 0x600u | (unsigned)(u.pm & 0xff), __ATOMIC_RELAXED, __ATOMIC_RELAXED, __HIP_MEMORY_SCOPE_AGENT); __hip_atomic_store(tmo, 1u, __ATOMIC_RELAXED, __HIP_MEMORY_SCOPE_AGENT); }
                    break; }
                __builtin_amdgcn_s_sleep(2); }
            __builtin_amdgcn_fence(__ATOMIC_ACQUIRE, "agent");
            asm volatile("s_waitcnt vmcnt(0)" ::: "memory");
        }
#if !defined(BROKEN_HOOK_NO_BARRIER)
        asm volatile("" ::: "memory"); __builtin_amdgcn_s_barrier(); asm volatile("" ::: "memory");
#endif
    }
};

__device__ __forceinline__ unsigned cvt_pk_bf16(float lo, float hi) { return ::cvtpk(lo, hi); }
typedef float f32x2 __attribute__((ext_vector_type(2)));
__device__ __forceinline__ f32x2 gelu_pk(f32x2 v) {
    const f32x2 av = __builtin_elementwise_abs(v), d = av * 0.2316418882f + 1.0f;
    f32x2 t; t.x = __builtin_amdgcn_rcpf(d.x); t.y = __builtin_amdgcn_rcpf(d.y);
    f32x2 q = t * 0.5307027145f + (-0.7265760135f); q = q * t + 0.7107068705f; q = q * t + (-0.142248368f); q = q * t + 0.127414796f; q = q * t;
    const f32x2 s = (v * v) * (-0.72134752044f);
    f32x2 e; e.x = __builtin_amdgcn_exp2f(s.x); e.y = __builtin_amdgcn_exp2f(s.y);
    const f32x2 m = v * (q * e), r = v - m;
    f32x2 o; o.x = v.x < 0.f ? m.x : r.x; o.y = v.y < 0.f ? m.y : r.y; return o;
}

struct EpiF32 {
    static constexpr bool PERM = false, AFTER_DRAIN = false;
    float* C; int ldc; const float* bias;
    __device__ __forceinline__ void operator()(const f32x4 (&acc)[2][2][4][2], const Unit& u, int wr, int wc, int fr, int fq) const {
        const int row0 = u.pm * BM + wr * 64 + fr, col0 = u.pn * BM + wc * 32 + 4 * fq;
        f32x4 bv[2][2];
#pragma unroll
        for (int bj = 0; bj < 2; ++bj)
#pragma unroll
            for (int n = 0; n < 2; ++n) bv[bj][n] = bias ? *(const f32x4*)(bias + col0 + bj * HALF + n * 16) : (f32x4){0.f, 0.f, 0.f, 0.f};
#pragma unroll
        for (int ai = 0; ai < 2; ++ai)
#pragma unroll
            for (int m = 0; m < 4; ++m) { float* rowp = C + (size_t)(row0 + ai * HALF + m * 16) * ldc + col0;
#pragma unroll
                for (int bj = 0; bj < 2; ++bj)
#pragma unroll
                    for (int n = 0; n < 2; ++n) *(f32x4*)(rowp + bj * HALF + n * 16) = acc[ai][bj][m][n] + bv[bj][n]; }
    }
};
template <int ACT  > struct EpiBf16 {
    static constexpr bool PERM = true, AFTER_DRAIN = false;
    bf16_t* O; int ldc; const float* bias; int split_cols; size_t split_stride;
    __device__ __forceinline__ void operator()(const f32x4 (&acc)[2][2][4][2], const Unit& u, int wr, int wc, int fr, int fq) const {
        const int row0 = u.pm * BM + wr * 64 + fr; int colt = u.pn * BM; bf16_t* base = O;
        if (split_cols) { const int t = colt / split_cols; base += (size_t)t * split_stride; colt -= t * split_cols; }
        const int col0 = colt + wc * 32 + 8 * fq, bcol0 = u.pn * BM + wc * 32 + 8 * fq;
        f32x4 bv[2][2];
#pragma unroll
        for (int bj = 0; bj < 2; ++bj)
#pragma unroll
            for (int n = 0; n < 2; ++n) bv[bj][n] = bias ? *(const f32x4*)(bias + bcol0 + bj * HALF + 4 * n) : (f32x4){0.f, 0.f, 0.f, 0.f};
#pragma unroll
        for (int ai = 0; ai < 2; ++ai)
#pragma unroll
            for (int m = 0; m < 4; ++m) { bf16_t* rowp = base + (size_t)(row0 + ai * HALF + m * 16) * ldc + col0;
#pragma unroll
                for (int bj = 0; bj < 2; ++bj) { f32x4 v0 = acc[ai][bj][m][0] + bv[bj][0], v1 = acc[ai][bj][m][1] + bv[bj][1];
                    if (ACT == 1) { f32x2 a = gelu_pk((f32x2){v0[0], v0[1]}), b = gelu_pk((f32x2){v0[2], v0[3]}), c = gelu_pk((f32x2){v1[0], v1[1]}), d = gelu_pk((f32x2){v1[2], v1[3]});
                        v0 = (f32x4){a.x, a.y, b.x, b.y}; v1 = (f32x4){c.x, c.y, d.x, d.y}; }
                    if (ACT == 2) {
#pragma unroll
                        for (int j = 0; j < 4; ++j) { v0[j] = 0.5f * v0[j] * (1.0f + erff(v0[j] * 0.70710678f)); v1[j] = 0.5f * v1[j] * (1.0f + erff(v1[j] * 0.70710678f)); } }
                    u32x4 w; w.x = cvt_pk_bf16(v0[0], v0[1]); w.y = cvt_pk_bf16(v0[2], v0[3]); w.z = cvt_pk_bf16(v1[0], v1[1]); w.w = cvt_pk_bf16(v1[2], v1[3]);
                    *(u32x4*)(rowp + bj * HALF) = w; } }
    }
};
template <class Epi, class Sched, bool STAMP = false>
__device__ __forceinline__ void gemm_phase(PG8_LAS unsigned char* lds, const Gemm g, const Sched& S, const Epi& E, unsigned long long* stamps) {
    int tid_ = threadIdx.x; asm volatile("" : "+v"(tid_));
    const int tid = tid_, wid = __builtin_amdgcn_readfirstlane(tid >> 6), lane = tid & 63, wr = wid >> 2, wc = wid & 3, fr = lane & 15, fq = lane >> 4;
    const int K = g.K, nt = K / BK, LDK = g.ldk ? g.ldk : g.K;
    int ts_lo = 0, ts_hi = 0, nts = 0; const unsigned long long rt_entry = STAMP ? (unsigned long long)wall_clock64() : 0ull;
#define PG8_STAMP() do { if (STAMP && wid == 0 && nts < 64) { const unsigned long long _c = (unsigned long long)clock64(); \
        ts_lo = (lane == nts) ? (int)(unsigned)_c : ts_lo; ts_hi = (lane == nts) ? (int)(unsigned)(_c >> 32) : ts_hi; ++nts; } } while (0)
    PG8_STAMP();
    unsigned voffA[2], voffB[2];
#pragma unroll
    for (int i = 0; i < 2; ++i) { int R, C; stage_rc(tid * 16 + i * 8192, R, C); const int Rb = Epi::PERM ? ((R & ~31) + perm32(R & 31)) : R;
        voffA[i] = (unsigned)(R * LDK + C) * 2u; voffB[i] = (unsigned)(Rb * LDK + C) * 2u; }
    const size_t kstep = (size_t)(BK * 2);
    const size_t hstep = (size_t)HALF * LDK * 2;
    const size_t tstep = 2 * hstep;
    const unsigned ldsw = (unsigned)wid * 1024u;
    const int aoff = lds_byte(wr * 64 + fr, fq * 8), boff = lds_byte(wc * 32 + fr, fq * 8);
#define PG8_SA(b, h) (((b) * 2 + (h)) * HTB)
#define PG8_SB(b, h) ((4 + (b) * 2 + (h)) * HTB)
#define PG8_STAGE(bufoff, gbase, voff) do { _Pragma("unroll") for (int _i = 0; _i < 2; ++_i) \
        __builtin_amdgcn_global_load_lds((const unsigned*)((const char*)(gbase) + (voff)[_i]), (PG8_LAS unsigned*)(lds + (bufoff) + ldsw + _i * 8192), 16, 0, 0); } while (0)
#define PG8_LDA(dst, b, h) do { _Pragma("unroll") for (int m = 0; m < 4; ++m) _Pragma("unroll") for (int k = 0; k < 2; ++k) dst[m][k] = *(const PG8_LAS bf16x8*)(lds + PG8_SA(b, h) + aoff + m * 2048 + k * 1024); } while (0)
#define PG8_LDB(dst, b, h) do { _Pragma("unroll") for (int n = 0; n < 2; ++n) _Pragma("unroll") for (int k = 0; k < 2; ++k) dst[n][k] = *(const PG8_LAS bf16x8*)(lds + PG8_SB(b, h) + boff + n * 2048 + k * 1024); } while (0)
#define PG8_MMA(ai, bj, At, Bt) do { __builtin_amdgcn_s_setprio(1); _Pragma("unroll") for (int m = 0; m < 4; ++m) _Pragma("unroll") for (int n = 0; n < 2; ++n) _Pragma("unroll") for (int k = 0; k < 2; ++k) \
        acc[ai][bj][m][n] = __builtin_amdgcn_mfma_f32_16x16x32_bf16(Bt[n][k], At[m][k], acc[ai][bj][m][n], 0, 0, 0); __builtin_amdgcn_s_setprio(0); } while (0)
#define PG8_WAIT_V(n) asm volatile("s_waitcnt vmcnt(" #n ")" ::: "memory")
#define PG8_WAIT_L(n) asm volatile("s_waitcnt lgkmcnt(" #n ")" ::: "memory")
#define PG8_BAR __builtin_amdgcn_s_barrier()
#define PG8_SCHED __builtin_amdgcn_sched_barrier(0)
    Unit cur, nxt; int ui = 0;
    if (!S.next(0, cur)) return;
    f32x4 acc[2][2][4][2];
#pragma unroll
    for (int a = 0; a < 2; ++a)
#pragma unroll
        for (int b = 0; b < 2; ++b)
#pragma unroll
            for (int m = 0; m < 4; ++m)
#pragma unroll
                for (int n = 0; n < 2; ++n) acc[a][b][m][n] = (f32x4){0.f, 0.f, 0.f, 0.f};
    bf16x8 At[4][2], B0[2][2], B1[2][2];
    const char* cA = (const char*)g.A + (size_t)cur.pm * tstep + (size_t)cur.koff * 2; const char* cB = (const char*)g.Bt + (size_t)cur.pn * tstep + (size_t)cur.koff * 2;
    S.a_ready(cur);
    PG8_STAGE(PG8_SB(0, 0), cB, voffB); PG8_STAGE(PG8_SA(0, 0), cA, voffA); PG8_STAGE(PG8_SB(0, 1), cB + hstep, voffB); PG8_STAGE(PG8_SA(0, 1), cA + hstep, voffA);
    if (wr == 1) PG8_BAR;
    PG8_WAIT_V(4); PG8_BAR;
    PG8_STAGE(PG8_SB(1, 0), cB + kstep, voffB); PG8_STAGE(PG8_SA(1, 0), cA + kstep, voffA); PG8_STAGE(PG8_SB(1, 1), cB + hstep + kstep, voffB);
    PG8_WAIT_V(6); PG8_BAR;
    PG8_STAMP();
    for (;;) {
        const bool has_next = S.next(ui + 1, nxt);
        const char* nA = has_next ? (const char*)g.A + (size_t)nxt.pm * tstep + (size_t)nxt.koff * 2 : cA; const char* nB = has_next ? (const char*)g.Bt + (size_t)nxt.pn * tstep + (size_t)nxt.koff * 2 : cB;
        for (int t = 0; t < nt; t += 2) {
            const bool last = (t == nt - 2);
            const char* a1 = cA + (size_t)(t + 1) * kstep;
            const char* a2 = last ? nA : cA + (size_t)(t + 2) * kstep; const char* b2 = last ? nB : cB + (size_t)(t + 2) * kstep;
            const char* a3 = a2 + kstep; const char* b3 = b2 + kstep;
            if (last && has_next) S.a_ready(nxt);
            PG8_LDB(B0, 0, 0); PG8_SCHED; PG8_LDA(At, 0, 0); PG8_STAGE(PG8_SA(1, 1), a1 + hstep, voffA);
            PG8_WAIT_L(8); PG8_BAR; PG8_WAIT_L(0); PG8_MMA(0, 0, At, B0); PG8_BAR; PG8_SCHED;
            PG8_LDB(B1, 0, 1); PG8_STAGE(PG8_SB(0, 0), b2, voffB);
            PG8_BAR; PG8_WAIT_L(0); PG8_MMA(0, 1, At, B1); PG8_BAR;
            PG8_LDA(At, 0, 1); PG8_STAGE(PG8_SA(0, 0), a2, voffA);
            PG8_BAR; PG8_WAIT_L(0); PG8_MMA(1, 0, At, B0); PG8_BAR; PG8_SCHED;
            PG8_STAGE(PG8_SB(0, 1), b2 + hstep, voffB);
            PG8_WAIT_V(6); PG8_BAR; PG8_MMA(1, 1, At, B1); PG8_BAR;
            PG8_LDB(B0, 1, 0); PG8_SCHED; PG8_LDA(At, 1, 0); PG8_STAGE(PG8_SA(0, 1), a2 + hstep, voffA);
            PG8_WAIT_L(8); PG8_BAR; PG8_WAIT_L(0); PG8_MMA(0, 0, At, B0); PG8_BAR; PG8_SCHED;
            PG8_LDB(B1, 1, 1); PG8_STAGE(PG8_SB(1, 0), b3, voffB);
            PG8_BAR; PG8_WAIT_L(0); PG8_MMA(0, 1, At, B1); PG8_BAR;
            PG8_LDA(At, 1, 1); PG8_STAGE(PG8_SA(1, 0), a3, voffA);
            PG8_BAR; PG8_WAIT_L(0); PG8_MMA(1, 0, At, B0); PG8_BAR; PG8_SCHED;
            PG8_STAGE(PG8_SB(1, 1), b3 + hstep, voffB);
            PG8_WAIT_V(6); PG8_BAR; PG8_MMA(1, 1, At, B1); PG8_BAR;
        }
        PG8_STAMP();
        bool keep = false;
        if constexpr (!Epi::AFTER_DRAIN) { if constexpr (Epi::INPLACE) keep = E.inplace(acc, cur, wr, wc, fr, fq); else E(acc, cur, wr, wc, fr, fq); S.done(cur); }
        PG8_STAMP();
        if (!has_next) break;
        if (!keep) {
#pragma unroll
        for (int a = 0; a < 2; ++a)
#pragma unroll
            for (int b = 0; b < 2; ++b)
#pragma unroll
                for (int m = 0; m < 4; ++m)
#pragma unroll
                    for (int n = 0; n < 2; ++n) acc[a][b][m][n] = (f32x4){0.f, 0.f, 0.f, 0.f};
        }
        cur = nxt; cA = nA; cB = nB; ++ui;
    }
    PG8_WAIT_V(0);
    if (wr == 0) PG8_BAR;
    PG8_BAR;
    if constexpr (Epi::AFTER_DRAIN) { E.fused(acc, cur, wr, wc, fr, fq, lds, wid, lane); S.done(cur); }
    PG8_STAMP();
    if (STAMP && wid == 0) { stamps[lane] = lane < nts ? (((unsigned long long)(unsigned)ts_hi << 32) | (unsigned)ts_lo) : 0ull;
        if (lane == 62) stamps[62] = rt_entry; if (lane == 63) stamps[63] = (unsigned long long)wall_clock64(); }
#undef PG8_STAMP
#undef PG8_SA
#undef PG8_SB
#undef PG8_STAGE
#undef PG8_LDA
#undef PG8_LDB
#undef PG8_MMA
#undef PG8_WAIT_V
#undef PG8_WAIT_L
#undef PG8_BAR
#undef PG8_SCHED
}
}

namespace pg8 {
struct SchedPlain {
    int nM, nN, G, c;
    __device__ void init(int M, int N, int G_, int c_) { nM = M / BM; nN = N / BM; G = G_; c = c_; }
    __device__ bool next(int i, Unit& u) const { const int L = i * G + c; if (L >= nM * nN) return false; u.pm = L % nM; u.pn = L / nM; u.aux = 0; u.koff = 0; return true; }
    __device__ __forceinline__ void a_ready(const Unit&) const {}
    __device__ __forceinline__ void done(const Unit&) const {}
};
struct SchedMerge {
    int nMr, G, c;
    __device__ bool next(int i, Unit& u) const { const int tile = (i / 3) * G + c, nb = i % 3; if (tile >= nMr * 4) return false; u.pm = nb * nMr + tile % nMr; u.pn = nb * 4 + tile / nMr; u.aux = nb; u.koff = 0; return true; }
    __device__ __forceinline__ void a_ready(const Unit&) const {}
    __device__ __forceinline__ void done(const Unit&) const {}
};
struct SchedMoe1 {
    const int* tile_exp; int t0, nt, G, c;
    __device__ bool next(int i, Unit& u) const { const int L = i * G + c; if (L >= nt * 28) return false; const int t = t0 + L % nt, j = L / nt; u.pm = t; u.pn = tile_exp[t] * 28 + j; u.aux = j; u.koff = 0; return true; }
    __device__ __forceinline__ void a_ready(const Unit&) const {}
    __device__ __forceinline__ void done(const Unit&) const {}
};
struct SchedMoe2 {
    const int* tile_exp; int t0, nt, G, c;
    __device__ bool next(int i, Unit& u) const { const int L = i * G + c; if (L >= nt * 4) return false; const int tl = L % nt, j = L / nt; u.pm = tl; u.pn = tile_exp[t0 + tl] * 4 + j; u.aux = (t0 + tl) * 4 + j; u.koff = 0; return true; }
    __device__ __forceinline__ void a_ready(const Unit&) const {}
    __device__ __forceinline__ void done(const Unit&) const {}
};
struct SchedMoe2K {
    const int* tile_exp; int t0, nt, G, c;
    __device__ bool next(int i, Unit& u) const { const int L = i * G + c; if (L >= nt * 16) return false; const int ks = L & 3, tl = (L >> 2) % nt, j = (L >> 2) / nt;
        u.pm = tl; u.pn = tile_exp[t0 + tl] * 4 + j; u.aux = (tl * 4 + j) * 4 + ks; u.koff = ks * 896; return true; }
    __device__ __forceinline__ void a_ready(const Unit&) const {}
    __device__ __forceinline__ void done(const Unit&) const {}
};

struct EpiStoreBf16 {
    static constexpr bool PERM = true, AFTER_DRAIN = false, INPLACE = false;
    bf16_t* O; int ldc; int mode;
    __device__ __forceinline__ void operator()(const f32x4 (&acc)[2][2][4][2], const Unit& u, int wr, int wc, int fr, int fq) const {
        float z0 = 0.f; asm volatile("" : "+v"(z0));
        const int rt = mode == 2 ? (u.aux >> 4) : (mode ? (u.aux >> 2) : u.pm), ct = mode == 2 ? ((u.aux >> 2) & 3) : (mode ? (u.aux & 3) : u.pn);
        const int row0 = rt * BM + wr * 64 + fr + (mode == 2 ? (u.aux & 3) * 2048 : 0), col0 = ct * BM + wc * 32 + 8 * fq;
#pragma unroll
        for (int ai = 0; ai < 2; ++ai)
#pragma unroll
            for (int m = 0; m < 4; ++m) { bf16_t* rowp = O + (size_t)(row0 + ai * HALF + m * 16) * ldc + col0;
#pragma unroll
                for (int bj = 0; bj < 2; ++bj) { const f32x4 v0 = acc[ai][bj][m][0] + z0, v1 = acc[ai][bj][m][1] + z0;
                    u32x4 w; w.x = cvt_pk_bf16(v0[0], v0[1]); w.y = cvt_pk_bf16(v0[2], v0[3]); w.z = cvt_pk_bf16(v1[0], v1[1]); w.w = cvt_pk_bf16(v1[2], v1[3]);
                    *(u32x4*)(rowp + bj * HALF) = w; } }
    }
};
struct EpiSwiGLU {
    static constexpr bool PERM = true, AFTER_DRAIN = false, INPLACE = false;
    bf16_t* O; int ldc; int mode; int t0;
    __device__ __forceinline__ void operator()(const f32x4 (&acc)[2][2][4][2], const Unit& u, int wr, int wc, int fr, int fq) const {
        const int rt = mode ? (u.pm - t0) : u.pm, ct = mode ? u.aux : u.pn;
        const int row0 = rt * BM + wr * 64 + fr, col0 = ct * HALF + wc * 32 + 8 * fq;
#pragma unroll
        for (int ai = 0; ai < 2; ++ai)
#pragma unroll
            for (int m = 0; m < 4; ++m) { bf16_t* rowp = O + (size_t)(row0 + ai * HALF + m * 16) * ldc + col0;
                float h[8];
#pragma unroll
                for (int n = 0; n < 2; ++n)
#pragma unroll
                    for (int j = 0; j < 4; ++j) { const float a = acc[ai][0][m][n][j], g = acc[ai][1][m][n][j]; h[n * 4 + j] = a * __builtin_amdgcn_rcpf(1.0f + __expf(-a)) * g; }
                u32x4 w; w.x = cvt_pk_bf16(h[0], h[1]); w.y = cvt_pk_bf16(h[2], h[3]); w.z = cvt_pk_bf16(h[4], h[5]); w.w = cvt_pk_bf16(h[6], h[7]);
                *(u32x4*)rowp = w; }
    }
};
struct EpiStoreF32 {
    static constexpr bool PERM = false, AFTER_DRAIN = false, INPLACE = false;
    float* C; int ldc;
    __device__ __forceinline__ void operator()(const f32x4 (&acc)[2][2][4][2], const Unit& u, int wr, int wc, int fr, int fq) const {
        const int row0 = u.pm * BM + wr * 64 + fr, col0 = u.pn * BM + wc * 32 + 4 * fq;
#pragma unroll
        for (int ai = 0; ai < 2; ++ai)
#pragma unroll
            for (int m = 0; m < 4; ++m) { float* rowp = C + (size_t)(row0 + ai * HALF + m * 16) * ldc + col0;
#pragma unroll
                for (int bj = 0; bj < 2; ++bj)
#pragma unroll
                    for (int n = 0; n < 2; ++n) *(f32x4*)(rowp + bj * HALF + n * 16) = acc[ai][bj][m][n]; }
    }
};
struct EpiMerge {
    static constexpr bool PERM = true, AFTER_DRAIN = false, INPLACE = true;
    const bf16_t* gate; int ldg;
    bf16_t* merged; int nMr;
    __device__ __forceinline__ bool inplace(f32x4 (&acc)[2][2][4][2], const Unit& u, int wr, int wc, int fr, int fq) const {
        const int nb = u.aux, rt = u.pm - nb * nMr, ct = u.pn - nb * 4;
        const int row0 = rt * BM + wr * 64 + fr, col0 = ct * BM + wc * 32 + 8 * fq;
        u32x4 ga[4][2], gb[4][2];
#define EM_LD(s, it, two) do { const bf16_t* gp_ = gate + (size_t)(row0 + ((it) >> 2) * HALF + ((it) & 3) * 16) * ldg + nb * 1024 + col0; \
            _Pragma("unroll") for (int bj_ = 0; bj_ < 2; ++bj_) { ga[s][bj_] = *(const u32x4*)(gp_ + bj_ * HALF); if (two) gb[s][bj_] = *(const u32x4*)(gp_ + 1024 + bj_ * HALF); } } while (0)
#define EM_UNPK(G_, W_) do { G_[0] = __uint_as_float(W_.x << 16); G_[1] = __uint_as_float(W_.x & 0xffff0000u); G_[2] = __uint_as_float(W_.y << 16); G_[3] = __uint_as_float(W_.y & 0xffff0000u); \
            G_[4] = __uint_as_float(W_.z << 16); G_[5] = __uint_as_float(W_.z & 0xffff0000u); G_[6] = __uint_as_float(W_.w << 16); G_[7] = __uint_as_float(W_.w & 0xffff0000u); } while (0)
        if (nb < 2) {
#pragma unroll
            for (int it = 0; it < 8; ++it) { const int s = it & 3, ai = it >> 2, m = it & 3;
                if (s == 0) { EM_LD(0, it, true); EM_LD(1, it + 1, true); EM_LD(2, it + 2, true); EM_LD(3, it + 3, true); }
#pragma unroll
                for (int bj = 0; bj < 2; ++bj) { float x[8], y[8]; const u32x4 wa = ga[s][bj], wb = gb[s][bj]; EM_UNPK(x, wa); EM_UNPK(y, wb);
#pragma unroll
                    for (int n = 0; n < 2; ++n)
#pragma unroll
                        for (int j = 0; j < 4; ++j) { const int e = n * 4 + j;
                            const float f = fmaxf(__builtin_amdgcn_rcpf(1.0f + __expf(-x[e])), 1e-18f) * fminf(1.0f + __expf(-y[e]), 1e18f);
                            acc[ai][bj][m][n][j] *= f; } } }
            return true;
        }
#pragma unroll
        for (int it = 0; it < 8; ++it) { const int s = it & 3, ai = it >> 2, m = it & 3; const size_t row = (size_t)(row0 + ai * HALF + m * 16);
            if (s == 0) { EM_LD(0, it, false); EM_LD(1, it + 1, false); EM_LD(2, it + 2, false); EM_LD(3, it + 3, false); }
#pragma unroll
            for (int bj = 0; bj < 2; ++bj) { const int col = col0 + bj * HALF; float x[8], v[8]; const u32x4 wa = ga[s][bj]; EM_UNPK(x, wa);
#pragma unroll
                for (int n = 0; n < 2; ++n)
#pragma unroll
                    for (int j = 0; j < 4; ++j) v[n * 4 + j] = acc[ai][bj][m][n][j] * fmaxf(__builtin_amdgcn_rcpf(1.0f + __expf(-x[n * 4 + j])), 1e-18f);
                u32x4 w; w.x = cvt_pk_bf16(v[0], v[1]); w.y = cvt_pk_bf16(v[2], v[3]); w.z = cvt_pk_bf16(v[4], v[5]); w.w = cvt_pk_bf16(v[6], v[7]);
                *(u32x4*)(merged + row * 1024 + col) = w; } }
#undef EM_LD
#undef EM_UNPK
        return false;
    }
};
}
#define XB_TMO      128
#define XB_XCNT(j)  (256  + 64 * (j))
#define XB_XSUB(j)  (1280 + 64 * (j))
#define XB_XGEN(j)  (2304 + 64 * (j))
#define XB_TOP      3328
#define XB_TOPGEN   3392
#define XCD_BAR_WORDS 3456
#define XB_SPIN_CAP (1u << 18)

__device__ __forceinline__ unsigned xb_ld(unsigned* p)              { return __hip_atomic_load(p, __ATOMIC_RELAXED, __HIP_MEMORY_SCOPE_AGENT); }
__device__ __forceinline__ unsigned xb_add(unsigned* p, unsigned v) { return __hip_atomic_fetch_add(p, v, __ATOMIC_RELAXED, __HIP_MEMORY_SCOPE_AGENT); }
__device__ __forceinline__ unsigned xb_xcc_id() { return (unsigned)__builtin_amdgcn_s_getreg((3 << 11) | 20) & 0xFu; }
#define XB_SPIN(cond, bar) do { unsigned _sp = 0; while (cond) { __builtin_amdgcn_s_sleep(1); \
    if ((++_sp & 255u) == 0u) { if (xb_ld(&(bar)[XB_TMO])) break; if (_sp > XB_SPIN_CAP) { atomicAdd(&(bar)[XB_TMO], 1u); break; } } } } while (0)

struct XcdBarrier {
    unsigned* bar; unsigned x;
    volatile LAS unsigned* st;
};

__device__ __forceinline__ XcdBarrier xcd_barrier_post(unsigned* bar, volatile LAS unsigned* st) {
    XcdBarrier b; b.bar = bar; b.x = xb_xcc_id(); b.st = st;
    if (threadIdx.x == 0) (void)xb_add(&bar[XB_XCNT(b.x)], 1u);
    return b;
}
__device__ __forceinline__ void xcd_barrier_complete(unsigned* bar, unsigned x, unsigned& nloc, unsigned& nx) {
    const unsigned G = gridDim.x * gridDim.y * gridDim.z;
    unsigned sum, cnt, mine, sp = 0u;
    for (;;) {
        sum = 0u; cnt = 0u; mine = 0u;
#pragma unroll
        for (unsigned j = 0; j < 16; ++j) { const unsigned c = xb_ld(&bar[XB_XCNT(j)]); sum += c; cnt += (c > 0u) ? 1u : 0u; mine = (j == x) ? c : mine; }
        if (sum == G) break;
        __builtin_amdgcn_s_sleep(1);
        if ((++sp & 255u) == 0u) { if (xb_ld(&bar[XB_TMO])) break; if (sp > XB_SPIN_CAP) { atomicAdd(&bar[XB_TMO], 1u); break; } }
    }
    nloc = mine > 0u ? mine : 1u; nx = cnt > 0u ? cnt : 1u;
}

__device__ __forceinline__ void xcd_barrier(const XcdBarrier& b) {
    asm volatile("s_waitcnt vmcnt(0)" ::: "memory");
    __syncthreads();
    if (threadIdx.x == 0) {
        unsigned* bar = b.bar;
        __builtin_amdgcn_s_waitcnt(0);
        unsigned nloc = b.st[0], nx = b.st[1];
        if (nloc == 0u) { xcd_barrier_complete(bar, b.x, nloc, nx); b.st[0] = nloc; b.st[1] = nx; }
        const unsigned old = xb_add(&bar[XB_XSUB(b.x)], 1u);
        const unsigned gen = old / nloc;
        if (old + 1u == (gen + 1u) * nloc) {
            __builtin_amdgcn_fence(__ATOMIC_RELEASE, "agent");
            asm volatile("s_waitcnt vmcnt(0)" ::: "memory");
            const unsigned og = xb_add(&bar[XB_TOP], 1u);
            const unsigned tg = og / nx;
            if (og + 1u == (tg + 1u) * nx) xb_add(&bar[XB_TOPGEN], 1u);
            else XB_SPIN(xb_ld(&bar[XB_TOPGEN]) == tg, bar);
            __builtin_amdgcn_fence(__ATOMIC_ACQUIRE, "agent");
            xb_add(&bar[XB_XGEN(b.x)], 1u);
            asm volatile("s_waitcnt vmcnt(0)" ::: "memory");
        } else {
            XB_SPIN(xb_ld(&bar[XB_XGEN(b.x)]) == gen, bar);
            __builtin_amdgcn_fence(__ATOMIC_ACQUIRE, "agent");
            asm volatile("s_waitcnt vmcnt(0)" ::: "memory");
        }
    }
    __syncthreads();
}

struct Ctx {
    const float* in[25]; float* out; unsigned char* ws;
    unsigned char* lds;
    int tid, lane, wave, wg, G;
};
#define IN_X 0
#define IN_C 1
#define IN_POS 2
#define IN_ADALN_W 3
#define IN_ADALN_B 4
#define IN_NORM_W 5
#define IN_W_IN 6
#define IN_GLA_UP 7
#define IN_GLA_BIAS 8
#define IN_GLA_NORM 9
#define IN_DIFF_LAMBDA 10
#define IN_DIFF_NORM 11
#define IN_GDN_CONV 12
#define IN_GDN_ALOG 13
#define IN_GDN_DTB 14
#define IN_GDN_NORM 15
#define IN_W_BRANCH 16
#define IN_W_OUT 17
#define IN_FFN_W1 18
#define IN_FFN_W3 19
#define IN_FFN_W2 20
#define IN_ROUTER 21
#define IN_MOE_W1 22
#define IN_MOE_W3 23
#define IN_MOE_W2 24

__device__ __forceinline__ void tr_item(const float* W, int K, int N, bf16* WT, int drow, float* scr, int k0, int n0, int lane) {
    const int kk0 = lane >> 3, nq = (lane & 7) * 4; f32x4 v[8];
    if (n0 + 32 <= N) {
#pragma unroll
        for (int i = 0; i < 8; ++i) v[i] = *(const f32x4*)(W + (size_t)(k0 + kk0 + 8 * i) * N + n0 + nq);
    } else {
#pragma unroll
        for (int i = 0; i < 8; ++i) { const float* p = W + (size_t)(k0 + kk0 + 8 * i) * N + n0 + nq;
            v[i].x = (n0 + nq < N) ? p[0] : 0.f; v[i].y = (n0 + nq + 1 < N) ? p[1] : 0.f; v[i].z = (n0 + nq + 2 < N) ? p[2] : 0.f; v[i].w = (n0 + nq + 3 < N) ? p[3] : 0.f; }
    }
#pragma unroll
    for (int i = 0; i < 8; ++i) { float* s = scr + (kk0 + 8 * i) * 33 + nq; s[0] = v[i].x; s[1] = v[i].y; s[2] = v[i].z; s[3] = v[i].w; }
    asm volatile("s_waitcnt lgkmcnt(0)" ::: "memory");
    const int c = lane & 7;
#pragma unroll
    for (int j = 0; j < 4; ++j) { const int n = (lane >> 3) + 8 * j; const float* s = scr + (8 * c) * 33 + n;
        u32x4 o; o.x = cvtpk(s[0 * 33], s[1 * 33]); o.y = cvtpk(s[2 * 33], s[3 * 33]); o.z = cvtpk(s[4 * 33], s[5 * 33]); o.w = cvtpk(s[6 * 33], s[7 * 33]);
        *(u32x4*)(WT + (size_t)(drow + n) * K + k0 + 8 * c) = o; }
    asm volatile("s_waitcnt lgkmcnt(0)" ::: "memory");
}
__device__ __forceinline__ void tr_matrix(Ctx& C, const float* W, int K, int N, int Npad, bf16* WT, int drow0, bool swi, int& base) {
    float* scr = (float*)(C.lds + C.wave * 8704);
    const int nblk = Npad / 32, nitems = (K / 64) * nblk, gw = C.wg * NWAVES + C.wave, NGW = C.G * NWAVES;
    int first = (gw - base % NGW + NGW) % NGW;
    for (int it = first; it < nitems; it += NGW) { const int kb = it / nblk, nb = it % nblk, n0 = nb * 32;
        const int drow = drow0 + (swi ? (n0 / 128) * 256 + (n0 % 128) : n0);
        tr_item(W, K, N, WT, drow, scr, kb * 64, n0, C.lane); }
    base += nitems;
}
__device__ __forceinline__ void convert_mixer_weights(Ctx& C, int l, int& base) {
    tr_matrix(C, C.in[IN_W_IN] + (size_t)l * DM * INC, DM, INC, LDP, (bf16*)(C.ws + WS_WIN), 0, false, base);
    for (int nb = 0; nb < 3; ++nb) tr_matrix(C, C.in[IN_W_BRANCH] + (size_t)(l * 3 + nb) * 512 * DM, 512, DM, DM, (bf16*)(C.ws + WS_WB) + (size_t)nb * 1024 * 512, 0, false, base);
    tr_matrix(C, C.in[IN_W_OUT] + (size_t)l * DM * DM, DM, DM, DM, (bf16*)(C.ws + WS_WO), 0, false, base);
}
__device__ __forceinline__ void convert_ffn_weights(Ctx& C, int& base) {
    tr_matrix(C, C.in[IN_FFN_W1], DM, DFF, DFF, (bf16*)(C.ws + WS_W13), 0, true, base);
    tr_matrix(C, C.in[IN_FFN_W3], DM, DFF, DFF, (bf16*)(C.ws + WS_W13), 128, true, base);
    tr_matrix(C, C.in[IN_FFN_W2], DFF, DM, DM, (bf16*)(C.ws + WS_W2), 0, false, base);
}
__device__ __forceinline__ void convert_moe_weights(Ctx& C, int& base) {
    for (int e = 0; e < NEXP; ++e) {
        tr_matrix(C, C.in[IN_MOE_W1] + (size_t)e * DM * DEXP, DM, DEXP, DEXP, (bf16*)(C.ws + WS_MW13) + (size_t)e * 2 * DEXP * DM, 0, true, base);
        tr_matrix(C, C.in[IN_MOE_W3] + (size_t)e * DM * DEXP, DM, DEXP, DEXP, (bf16*)(C.ws + WS_MW13) + (size_t)e * 2 * DEXP * DM, 128, true, base);
        tr_matrix(C, C.in[IN_MOE_W2] + (size_t)e * DEXP * DM, DEXP, DM, DM, (bf16*)(C.ws + WS_MW2) + (size_t)e * DM * DEXP, 0, false, base);
    }
}

__device__ __forceinline__ void mod_partials(Ctx& C) {
    float* sm = (float*)(C.lds + 8 * 8704);
    float* modp = (float*)(C.ws + WS_MODP);
    for (int item = C.wg; item < 192; item += C.G) {
        const int l = item / 96, r = item % 96, ec = r / 8, dp = r % 8;
        __syncthreads();
        { const int b = C.tid >> 7, dd = C.tid & 127; const float cv = C.in[IN_C][b * DM + dp * 128 + dd]; sm[C.tid] = cv / (1.0f + __expf(-cv)); }
        __syncthreads();
        const int e = ec * 512 + C.tid; float a0 = 0.f, a1 = 0.f, a2 = 0.f, a3 = 0.f;
        const float* wp = C.in[IN_ADALN_W] + ((size_t)l * DM + dp * 128) * 6144 + e;
#pragma unroll 32
        for (int dd = 0; dd < 128; ++dd) { const float w = wp[(size_t)dd * 6144]; a0 += sm[dd] * w; a1 += sm[128 + dd] * w; a2 += sm[256 + dd] * w; a3 += sm[384 + dd] * w; }
        float* o = modp + ((size_t)(dp * 2 + l) * 4) * 6144 + e;
        o[0] = a0; o[6144] = a1; o[2 * 6144] = a2; o[3 * 6144] = a3;
    }
}
__device__ __forceinline__ float mod_val(const Ctx& C, int l, int b, int k, int c) {
    const float* modp = (const float*)(C.ws + WS_MODP);
    float s = C.in[IN_ADALN_B][l * 6144 + k * 1024 + c];
#pragma unroll
    for (int dp = 0; dp < 8; ++dp) s += modp[((size_t)(dp * 2 + l) * 4 + b) * 6144 + k * 1024 + c];
    return s;
}

__device__ __forceinline__ float mod_fin(const Ctx& C, int l, int b, int k, int c) { return ((const float*)(C.ws + WS_MODF))[(size_t)(l * 4 + b) * 6144 + k * 1024 + c]; }

__device__ __forceinline__ void phase_norm_in(Ctx& C, const float* x, int l) {
    float* vA = (float*)C.lds; float* vB = vA + 1024;
    const int rows_per_wg = TOK / C.G;
    const int r0 = C.wg * rows_per_wg, b = r0 / SEQ;
    __syncthreads();
    for (int c = C.tid; c < DM; c += NTHREADS) { vA[c] = C.in[IN_NORM_W][(l * 4 + 0) * DM + c] * (1.0f + mod_val(C, l, b, 1, c)); vB[c] = mod_val(C, l, b, 0, c); }
    __syncthreads();
    for (int i = C.wg * NTHREADS + C.tid; i < 2 * 4 * 6144; i += C.G * NTHREADS) { const int l2 = i / (4 * 6144), r2 = i % (4 * 6144), b2 = r2 / 6144, e2 = r2 % 6144;
        ((float*)(C.ws + WS_MODF))[i] = mod_val(C, l2, b2, e2 >> 10, e2 & 1023); }
    if (C.wg == 0 && C.tid < 2) { const float* lp = C.in[IN_DIFF_LAMBDA] + C.tid * 256; float s1 = 0.f, s2 = 0.f;
        for (int i = 0; i < 64; ++i) { s1 += lp[i] * lp[64 + i]; s2 += lp[128 + i] * lp[192 + i]; }
        ((float*)(C.ws + WS_MODF))[49152 + C.tid] = __expf(s1) - __expf(s2) + (0.8f - 0.6f * __expf(-0.3f * (float)C.tid)); }
    bf16* H = (bf16*)(C.ws + WS_H);
    for (int r = r0 + C.wave; r < r0 + rows_per_wg; r += NWAVES) {
        const f32x4* xr = (const f32x4*)(x + (size_t)r * DM) + C.lane; f32x4 v[4]; float s = 0.f;
#pragma unroll
        for (int j = 0; j < 4; ++j) { v[j] = xr[64 * j]; s += v[j].x * v[j].x + v[j].y * v[j].y + v[j].z * v[j].z + v[j].w * v[j].w; }
        const float rs = rsqrtf(wave_sum(s) * (1.0f / DM) + EPS);
        u32x2* o = (u32x2*)(H + (size_t)r * DM) + C.lane;
#pragma unroll
        for (int j = 0; j < 4; ++j) { const int c = 4 * C.lane + 256 * j; const f32x4 a = *(const f32x4*)(vA + c), bb = *(const f32x4*)(vB + c);
            u32x2 w; w.x = cvtpk(v[j].x * rs * a.x + bb.x, v[j].y * rs * a.y + bb.y); w.y = cvtpk(v[j].z * rs * a.z + bb.z, v[j].w * rs * a.w + bb.w); o[64 * j] = w; }
    }
}
__device__ __forceinline__ void phase_resnorm(Ctx& C, int row_lo, int nrows, const float* xold, const float* ysrc, int yrow0, bool from_slots,
                                              int l, int kg, int nwres, bool do_h, int ln, int ksc, int ksh, int nwn, bool do_route, int grp0) {
    float* vG = (float*)C.lds; float* vA = vG + 1024; float* vB = vA + 1024; float* Wr = vB + 1024;
    int* cnt = (int*)(Wr + 8192);
    const int rows_per_wg = nrows / C.G, r0 = row_lo + C.wg * rows_per_wg, b = r0 / SEQ;
    __syncthreads();
    for (int c = C.tid; c < DM; c += NTHREADS) {
        vG[c] = mod_fin(C, l, b, kg, c) * C.in[IN_NORM_W][(l * 4 + nwres) * DM + c];
        if (do_h) { vA[c] = C.in[IN_NORM_W][(ln * 4 + nwn) * DM + c] * (1.0f + mod_fin(C, ln, b, ksc, c)); vB[c] = mod_fin(C, ln, b, ksh, c); } }
    if (do_route) { for (int i = C.tid; i < DM * NEXP; i += NTHREADS) Wr[i] = C.in[IN_ROUTER][i]; if (C.tid < 8) cnt[C.tid] = 0; }
    __syncthreads();
    bf16* H = (bf16*)(C.ws + WS_H);
    const uint4* route = (const uint4*)(C.ws + WS_ROUTE); const int* slotrow = (const int*)(C.ws + WS_SLOTROW); const bf16* ys = (const bf16*)(C.ws + WS_ASORT);
    struct RowIn { f32x4 y[4]; f32x4 x[4]; u32x2 a[4], b[4]; float w0, w1; int s0, s1; };
    const bf16* mp = (const bf16*)(C.ws + WS_MPART);
    auto load_row = [&](RowIn& in, int r) {
        if (!from_slots) { const u32x2* yr = (const u32x2*)((const bf16*)ysrc + (size_t)(r - yrow0) * DM) + C.lane;
#pragma unroll
            for (int j = 0; j < 4; ++j) in.a[j] = yr[64 * j]; }
        else { const uint4 rt = route[r]; in.w0 = __uint_as_float(rt.z); in.w1 = __uint_as_float(rt.w);
            const int s0 = slotrow[2 * r], s1 = slotrow[2 * r + 1]; in.s0 = s0; in.s1 = s1;
            const u32x2* y0 = (const u32x2*)((s0 < 65536 ? ys : mp - (size_t)65536 * DM) + (size_t)s0 * DM) + C.lane; const u32x2* y1 = (const u32x2*)((s1 < 65536 ? ys : mp - (size_t)65536 * DM) + (size_t)s1 * DM) + C.lane;
#pragma unroll
            for (int j = 0; j < 4; ++j) { in.a[j] = y0[64 * j]; in.b[j] = y1[64 * j]; } }
        const f32x4* xr = (const f32x4*)(xold + (size_t)r * DM) + C.lane;
#pragma unroll
        for (int j = 0; j < 4; ++j) in.x[j] = xr[64 * j];
    };
    auto proc_row = [&](RowIn& in, int r) {
        f32x4 y[4]; float s = 0.f;
        if (!from_slots) {
#pragma unroll
            for (int j = 0; j < 4; ++j) { const u32x2 a = in.a[j]; y[j].x = bflo(a.x); y[j].y = bfhi(a.x); y[j].z = bflo(a.y); y[j].w = bfhi(a.y); } }
        else { const float w0 = in.w0, w1 = in.w1;
#pragma unroll
            for (int j = 0; j < 4; ++j) { const u32x2 a = in.a[j], bb = in.b[j];
                y[j].x = w0 * bflo(a.x) + w1 * bflo(bb.x); y[j].y = w0 * bfhi(a.x) + w1 * bfhi(bb.x); y[j].z = w0 * bflo(a.y) + w1 * bflo(bb.y); y[j].w = w0 * bfhi(a.y) + w1 * bfhi(bb.y); }
#pragma unroll
            for (int sl = 0; sl < 2; ++sl) { const int sr_ = sl ? in.s1 : in.s0; const float ww = sl ? w1 : w0;
                if (sr_ >= 65536) { for (int ks = 1; ks < 4; ++ks) { const u32x2* yp = (const u32x2*)(mp + ((size_t)ks * 2048 + (sr_ - 65536)) * DM) + C.lane;
#pragma unroll
                        for (int j = 0; j < 4; ++j) { const u32x2 a = yp[64 * j]; y[j].x += ww * bflo(a.x); y[j].y += ww * bfhi(a.x); y[j].z += ww * bflo(a.y); y[j].w += ww * bfhi(a.y); } } } } }
#pragma unroll
        for (int j = 0; j < 4; ++j) s += y[j].x * y[j].x + y[j].y * y[j].y + y[j].z * y[j].z + y[j].w * y[j].w;
        const float rs = rsqrtf(wave_sum(s) * (1.0f / DM) + EPS);
        f32x4* xo = (f32x4*)(C.out + (size_t)r * DM) + C.lane;
        f32x4 xn[4]; float s2 = 0.f;
#pragma unroll
        for (int j = 0; j < 4; ++j) { const int c = 4 * C.lane + 256 * j; const f32x4 g = *(const f32x4*)(vG + c); const f32x4 xv = in.x[j];
            xn[j].x = xv.x + g.x * (y[j].x * rs); xn[j].y = xv.y + g.y * (y[j].y * rs); xn[j].z = xv.z + g.z * (y[j].z * rs); xn[j].w = xv.w + g.w * (y[j].w * rs);
            xo[64 * j] = xn[j]; s2 += xn[j].x * xn[j].x + xn[j].y * xn[j].y + xn[j].z * xn[j].z + xn[j].w * xn[j].w; }
        if (do_h) {
            const float rs2 = rsqrtf(wave_sum(s2) * (1.0f / DM) + EPS);
            u32x2* o = (u32x2*)(H + (size_t)r * DM) + C.lane; float lg[8];
#pragma unroll
            for (int e = 0; e < 8; ++e) lg[e] = 0.f;
#pragma unroll
            for (int j = 0; j < 4; ++j) { const int c = 4 * C.lane + 256 * j; const f32x4 a = *(const f32x4*)(vA + c), bb = *(const f32x4*)(vB + c);
                float hv[4]; hv[0] = xn[j].x * rs2 * a.x + bb.x; hv[1] = xn[j].y * rs2 * a.y + bb.y; hv[2] = xn[j].z * rs2 * a.z + bb.z; hv[3] = xn[j].w * rs2 * a.w + bb.w;
                u32x2 w; w.x = cvtpk(hv[0], hv[1]); w.y = cvtpk(hv[2], hv[3]); o[64 * j] = w;
                if (do_route) {
#pragma unroll
                    for (int q = 0; q < 4; ++q) { const f32x4 wa = *(const f32x4*)(Wr + (c + q) * 8), wb = *(const f32x4*)(Wr + (c + q) * 8 + 4);
                        lg[0] += hv[q] * wa.x; lg[1] += hv[q] * wa.y; lg[2] += hv[q] * wa.z; lg[3] += hv[q] * wa.w; lg[4] += hv[q] * wb.x; lg[5] += hv[q] * wb.y; lg[6] += hv[q] * wb.z; lg[7] += hv[q] * wb.w; } } }
            if (do_route) {
#pragma unroll
                for (int e = 0; e < 8; ++e) lg[e] = wave_sum(lg[e]);
                int i0 = 0; float v0 = lg[0];
#pragma unroll
                for (int e = 1; e < 8; ++e) if (lg[e] > v0) { v0 = lg[e]; i0 = e; }
                int i1 = -1; float v1 = -3.0e38f;
#pragma unroll
                for (int e = 0; e < 8; ++e) if (e != i0 && lg[e] > v1) { v1 = lg[e]; i1 = e; }
                const float w0 = 1.0f / (1.0f + __expf(v1 - v0)), w1 = 1.0f - w0;
                if (C.lane == 0) { const int p0 = atomicAdd(&cnt[i0], 1), p1 = atomicAdd(&cnt[i1], 1);
                    ((uint4*)(C.ws + WS_ROUTE))[r] = make_uint4((unsigned)i0, (unsigned)i1, __float_as_uint(w0), __float_as_uint(w1));
                    int* lpos = (int*)(C.ws + WS_LPOS); lpos[2 * r] = p0; lpos[2 * r + 1] = p1; }
            }
        }
    };
    { RowIn A, B; const int rend = r0 + rows_per_wg; int r = r0 + C.wave;
        load_row(A, r);
        for (; r < rend; r += 2 * NWAVES) { const int r2 = r + NWAVES, r3 = r + 2 * NWAVES;
            if (r2 < rend) load_row(B, r2);
            proc_row(A, r);
            if (r2 < rend) { if (r3 < rend) load_row(A, r3); proc_row(B, r2); } } }
    __syncthreads();
    if (do_route) { if (C.tid < 8) ((int*)(C.ws + WS_GCNT))[(grp0 + C.wg) * 8 + C.tid] = cnt[C.tid]; __syncthreads(); }
}

namespace ck {
using bf16x8 = __attribute__((ext_vector_type(8))) short;
using f32x16 = __attribute__((ext_vector_type(16))) float;
__device__ __forceinline__ int crow(int r, int hi) { return (r & 3) + 8 * (r >> 2) + 4 * hi; }
template <int KS> __device__ __forceinline__ void mma(f32x16& acc, const bf16* ap, const bf16* bp) {
#pragma unroll
    for (int s = 0; s < KS; ++s) { const bf16x8 a = *(const bf16x8*)(ap + 16 * s); const bf16x8 b = *(const bf16x8*)(bp + 16 * s); acc = __builtin_amdgcn_mfma_f32_32x32x16_bf16(a, b, acc, 0, 0, 0); }
}
__device__ __forceinline__ void settle() { asm volatile("s_nop 15\n\ts_nop 3" ::: "memory"); }
__device__ __forceinline__ f32x16 zero16() { f32x16 z;
#pragma unroll
    for (int i = 0; i < 16; ++i) z[i] = 0.f;
    return z; }
}

__device__ __forceinline__ void proj_tail_unit(Ctx& C, int hb) {
    int tid_ = threadIdx.x; asm volatile("" : "+v"(tid_));
    const int tid = tid_, lane = tid & 63, wv = __builtin_amdgcn_readfirstlane(tid >> 6), r32 = lane & 31, hi = lane >> 5, rt = wv & 1, ks = wv >> 1;
    const bf16* ap = (const bf16*)(C.ws + WS_H) + ((size_t)hb * HBR + C.wg * 64 + rt * 32 + r32) * DM + ks * 256 + 8 * hi;
    const bf16* bp = (const bf16*)(C.ws + WS_WIN) + (size_t)(8192 + r32) * DM + ks * 256 + 8 * hi;
    ck::f32x16 a0 = ck::zero16(), a1 = ck::zero16();
#pragma unroll
    for (int hf = 0; hf < 2; ++hf) {
        ck::bf16x8 av[8], b0v[8], b1v[8];
#pragma unroll
        for (int s = 0; s < 8; ++s) { av[s] = *(const ck::bf16x8*)(ap + 16 * (8 * hf + s)); b0v[s] = *(const ck::bf16x8*)(bp + 16 * (8 * hf + s)); b1v[s] = *(const ck::bf16x8*)(bp + 32 * DM + 16 * (8 * hf + s)); }
        __builtin_amdgcn_sched_barrier(0);
#pragma unroll
        for (int s = 0; s < 8; ++s) { a0 = __builtin_amdgcn_mfma_f32_32x32x16_bf16(av[s], b0v[s], a0, 0, 0, 0); a1 = __builtin_amdgcn_mfma_f32_32x32x16_bf16(av[s], b1v[s], a1, 0, 0, 0); }
        __builtin_amdgcn_sched_barrier(0);
    }
    float* red = (float*)C.lds;
    __syncthreads();
#pragma unroll
    for (int i = 0; i < 16; ++i) { red[(((ks * 2 + rt) * 2 + 0) * 16 + i) * 64 + lane] = a0[i]; red[(((ks * 2 + rt) * 2 + 1) * 16 + i) * 64 + lane] = a1[i]; }
    __syncthreads();
    bf16* proj = (bf16*)(C.ws + WS_PROJ) + (size_t)(C.wg * 64) * LDP + 8192;
#pragma unroll
    for (int q = 0; q < 8; ++q) { const int idx = q * 512 + tid, ln = idx & 63, i = (idx >> 6) & 15, nt = (idx >> 10) & 1, r = idx >> 11;
        float s = 0.f;
#pragma unroll
        for (int k2 = 0; k2 < 4; ++k2) s += red[(((k2 * 2 + r) * 2 + nt) * 16 + i) * 64 + ln];
        const int col = nt * 32 + (ln & 31), row = r * 32 + ck::crow(i, ln >> 5);
        if (col < 48) proj[(size_t)row * LDP + col] = f2bf(s); }
    __syncthreads();
}

__device__ __forceinline__ void phase_rope(Ctx& C, int hb) {
    bf16* proj = (bf16*)(C.ws + WS_PROJ);
    const int tpw = HBR / (C.G * NWAVES), gw = C.wg * NWAVES + C.wave, lane = C.lane;
    const float inv_f = __expf(-13.122363377404328f * (float)(lane & 7) * 0.125f);
    const float pos = (float)((const int*)C.in[IN_POS])[hb * HBR + gw * tpw + (lane >> 3)]; float sn, cs; sincosf(pos * inv_f, &sn, &cs);
    u32x4 w0[8], w1[8];
#pragma unroll
    for (int tk = 0; tk < 8; ++tk) { const bf16* hp = proj + (size_t)(gw * tpw + tk) * LDP + (lane < 8 ? C_DQ + lane * 64 : C_DK + (lane & 7) * 64);
        w0[tk] = (u32x4){0, 0, 0, 0}; w1[tk] = (u32x4){0, 0, 0, 0}; if (lane < 16) { w0[tk] = *(const u32x4*)hp; w1[tk] = *(const u32x4*)(hp + 8); } }
#pragma unroll
    for (int tk = 0; tk < 8; ++tk) { bf16* hp = proj + (size_t)(gw * tpw + tk) * LDP + (lane < 8 ? C_DQ + lane * 64 : C_DK + (lane & 7) * 64);
        float x1[8], x2[8], o1[8], o2[8]; unpack8(w0[tk], x1); unpack8(w1[tk], x2);
#pragma unroll
        for (int i = 0; i < 8; ++i) { const float c_ = __shfl(cs, tk * 8 + i), s_ = __shfl(sn, tk * 8 + i); o1[i] = x1[i] * c_ - x2[i] * s_; o2[i] = x2[i] * c_ + x1[i] * s_; }
        if (lane < 16) { *(u32x4*)hp = pack8(o1); *(u32x4*)(hp + 8) = pack8(o2); } }
}

__device__ __forceinline__ void gdn_prep_setup(Ctx& C, int l) {
    bf16* cwl = (bf16*)(C.lds + 122880);
    __syncthreads();
    for (int i = C.tid; i < 4 * 1536; i += NTHREADS) cwl[i] = f2bf(C.in[IN_GDN_CONV][(size_t)l * 4 * 1536 + i]);
    __syncthreads();
}
__device__ __forceinline__ void gdn_prep_unit(Ctx& C, int uidx, int l) {
    const int cn = uidx & 127, h = (uidx >> 7) & 3, sq = uidx >> 9;
    int tid_ = threadIdx.x; asm volatile("" : "+v"(tid_));
    const int tid = tid_, lane = tid & 63, wv = __builtin_amdgcn_readfirstlane(tid >> 6), r32 = lane & 31, hi = lane >> 5;
    bf16* Kn = (bf16*)C.lds; bf16* Qn = Kn + 64 * 136; bf16* Vn = Qn + 64 * 136;
    float* KKr = (float*)(C.lds + 51200); float* QKr = KKr + 64 * 68; float* MM = QKr + 64 * 68;
    float* gl = MM + 2 * 64 * 68; float* be = gl + 128; float* bq = be + 128; float* eb = bq + 128;
    const bf16* proj = (const bf16*)(C.ws + WS_PROJ) + (size_t)sq * SEQ * LDP;
    const int rowb = sq * SEQ + cn * 64;
    { const int lr = tid >> 3, c16 = (tid & 7) * 16, tpos = cn * 64 + lr; const bf16* cwl = (const bf16*)(C.lds + 122880);
        u32x4 raw[3][4][2];
#pragma unroll
        for (int mat = 0; mat < 3; ++mat)
#pragma unroll
            for (int j = 0; j < 4; ++j) { const int tt = tpos - 1 + j; const bool ok = (tt >= 0 && tt < SEQ); const bf16* p = proj + (size_t)(ok ? tt : tpos) * LDP + C_NQ + mat * 512 + h * 128 + c16;
                const u32x4 w0 = *(const u32x4*)p, w1 = *(const u32x4*)(p + 8); raw[mat][j][0] = ok ? w0 : (u32x4){0, 0, 0, 0}; raw[mat][j][1] = ok ? w1 : (u32x4){0, 0, 0, 0}; }
#pragma unroll
        for (int mat = 0; mat < 3; ++mat) {
            const int col = mat * 512 + h * 128 + c16; float acc[16];
#pragma unroll
            for (int i = 0; i < 16; ++i) acc[i] = 0.f;
#pragma unroll
            for (int j = 0; j < 4; ++j) { float xv[16], wv_[16]; unpack8(raw[mat][j][0], xv); unpack8(raw[mat][j][1], xv + 8);
                unpack8(*(const u32x4*)(cwl + j * 1536 + col), wv_); unpack8(*(const u32x4*)(cwl + j * 1536 + col + 8), wv_ + 8);
#pragma unroll
                for (int i = 0; i < 16; ++i) acc[i] += wv_[i] * xv[i]; }
            float ss = 0.f;
#pragma unroll
            for (int i = 0; i < 16; ++i) { acc[i] = siluf_(acc[i]); ss += acc[i] * acc[i]; }
            if (mat < 2) { ss = grp8_sum(ss); const float sc = rsqrtf(ss + EPS) * (mat == 0 ? 0.08838834764831845f : 1.0f);
#pragma unroll
                for (int i = 0; i < 16; ++i) acc[i] *= sc; }
            const u32x4 o0 = pack8(acc), o1 = pack8(acc + 8);
            if (mat == 0) { *(u32x4*)(Qn + lr * 136 + c16) = o0; *(u32x4*)(Qn + lr * 136 + c16 + 8) = o1;
                bf16* qg = (bf16*)(C.ws + WS_QN) + (size_t)(rowb + lr) * 512 + h * 128 + c16; *(u32x4*)qg = o0; *(u32x4*)(qg + 8) = o1; }
            else if (mat == 1) { *(u32x4*)(Kn + lr * 136 + c16) = o0; *(u32x4*)(Kn + lr * 136 + c16 + 8) = o1; }
            else { *(u32x4*)(Vn + lr * 128 + c16) = o0; *(u32x4*)(Vn + lr * 128 + c16 + 8) = o1; }
        } }
    if (tid < 128) { const int d = tid >> 6, i = tid & 63; const bf16* p = proj + (size_t)(cn * 64 + i) * LDP;
        const float bl = bf2f(p[C_NBF + d * 4 + h]), al = bf2f(p[C_NAF + d * 4 + h]);
        const float z = al + C.in[IN_GDN_DTB][(l * 2 + d) * 4 + h]; const float sp = z > 20.f ? z : log1pf(__expf(z));
        gl[d * 64 + i] = -__expf(C.in[IN_GDN_ALOG][(l * 2 + d) * 4 + h]) * sp; be[d * 64 + i] = sigmoidf_(bl); }
    __syncthreads();
    if (tid < 128) { const int d = tid >> 6, ip = tid & 63; float s = 0.f;
        for (int jp = 0; jp <= ip; ++jp) s += gl[d * 64 + (d ? 63 - jp : jp)];
        bq[d * 64 + ip] = s; eb[d * 64 + ip] = __expf(s);
        ((float*)(C.ws + WS_GB))[((size_t)d * 1024 + uidx) * 64 + ip] = s; }
    { const int w4 = wv & 3, ti = w4 >> 1, tj = w4 & 1; ck::f32x16 acc = ck::zero16();
        const bf16* ap = Kn + (32 * tj + r32) * 136 + 8 * hi; const bf16* bp = (wv < 4 ? Kn : Qn) + (32 * ti + r32) * 136 + 8 * hi;
        ck::mma<8>(acc, ap, bp);
        float* dst = (wv < 4 ? KKr : QKr) + (32 * ti + r32) * 68 + 32 * tj + 4 * hi;
#pragma unroll
        for (int g = 0; g < 4; ++g) *(f32x4*)(dst + 8 * g) = (f32x4){acc[4 * g], acc[4 * g + 1], acc[4 * g + 2], acc[4 * g + 3]}; }
    __syncthreads();
    { const int d = tid >> 8, t = tid & 255, ip = t >> 2, jp0 = (t & 3) * 16, i = d ? 63 - ip : ip; const float bi = bq[d * 64 + ip], bti = be[d * 64 + i]; float at[16];
#pragma unroll
        for (int jj = 0; jj < 16; ++jj) { const int jp = jp0 + jj, j = d ? 63 - jp : jp; const float gam = (jp <= ip) ? __expf(bi - bq[d * 64 + jp]) : 0.f;
            MM[(d * 64 + ip) * 68 + jp] = (jp < ip) ? bti * KKr[i * 68 + j] * gam : 0.f; at[jj] = QKr[i * 68 + j] * gam; }
        bf16* ag = (bf16*)(C.ws + WS_ATT) + (((size_t)d * 1024 + uidx) * 64 + ip) * 64 + jp0; *(u32x4*)ag = pack8(at); *(u32x4*)(ag + 8) = pack8(at + 8); }
    { const int dd = tid & 127, jb = tid >> 7; float kv[16];
#pragma unroll
        for (int jj = 0; jj < 16; ++jj) kv[jj] = bf2f(Kn[(jb * 16 + jj) * 136 + dd]);
        bf16* kg = (bf16*)(C.ws + WS_KT) + ((size_t)uidx * 128 + dd) * 64 + jb * 16; *(u32x4*)kg = pack8(kv); *(u32x4*)(kg + 8) = pack8(kv + 8); }
    __syncthreads();
    if (wv < 4) { typedef float f32x2 __attribute__((ext_vector_type(2)));
        const int d = wv >> 1, t = tid & 127; const float* Mr = MM + d * 64 * 68; f32x2 x[64];
#pragma unroll
        for (int i = 0; i < 64; ++i) x[i] = (f32x2){0.f, 0.f};
        bf16* ogu = (bf16*)(C.ws + WS_U) + (((size_t)d * 1024 + uidx) * 128 + t) * 64;            bf16* ogw = (bf16*)(C.ws + WS_W) + ((size_t)d * HBR + rowb) * 512 + h * 128 + t;
        int i = d ? 63 : 0; const int istep = d ? -1 : 1;
        f32x4 mb[2][4][2];
#define SV_LOAD(bf, bk, ch) do { _Pragma("unroll") for (int r_ = 0; r_ < 4; ++r_) _Pragma("unroll") for (int q_ = 0; q_ < 2; ++q_) mb[bf][r_][q_] = *(const f32x4*)(Mr + (4 * (bk) + r_) * 68 + 8 * (ch) + 4 * q_); } while (0)
        SV_LOAD(0, 1, 0);
#pragma unroll
        for (int blk = 0; blk < 16; ++blk) { asm volatile("" : "+v"(i));
            const int nch = (blk + 1) / 2, sb = (blk / 2) * ((blk + 1) / 2);
            f32x2 a[4];
#pragma unroll
            for (int r = 0; r < 4; ++r) { const int ii = i + r * istep; const float bt = be[d * 64 + ii]; a[r] = (f32x2){bt * bf2f(Vn[ii * 128 + t]), bt * eb[d * 64 + 4 * blk + r] * bf2f(Kn[ii * 136 + t])}; }
            const f32x4 m1 = *(const f32x4*)(Mr + (4 * blk + 1) * 68 + 4 * blk), m2 = *(const f32x4*)(Mr + (4 * blk + 2) * 68 + 4 * blk), m3 = *(const f32x4*)(Mr + (4 * blk + 3) * 68 + 4 * blk);
#pragma unroll
            for (int ch = 0; ch < nch; ++ch) { const int bf = (sb + ch) & 1;
                if (ch + 1 < nch) SV_LOAD(bf ^ 1, blk, ch + 1); else if (blk + 1 < 16) SV_LOAD(bf ^ 1, blk + 1, 0);
#pragma unroll
                for (int r = 0; r < 4; ++r)
#pragma unroll
                    for (int q = 0; q < 2; ++q) { const f32x4 m = mb[bf][r][q];
                        a[r] -= m.x * x[8 * ch + 4 * q]; a[r] -= m.y * x[8 * ch + 4 * q + 1]; a[r] -= m.z * x[8 * ch + 4 * q + 2]; a[r] -= m.w * x[8 * ch + 4 * q + 3]; } }
            a[1] -= m1.x * a[0]; a[2] -= m2.x * a[0]; a[2] -= m2.y * a[1]; a[3] -= m3.x * a[0]; a[3] -= m3.y * a[1]; a[3] -= m3.z * a[2];
#pragma unroll
            for (int r = 0; r < 4; ++r) { const int ii = i + r * istep; x[4 * blk + r] = a[r]; ogw[(size_t)ii * 512] = f2bf(a[r].y); }
            { u32x2 uw; uw.x = cvtpk(a[0].x, a[1].x); uw.y = cvtpk(a[2].x, a[3].x); *(u32x2*)(ogu + 4 * blk) = uw; }
            i += 4 * istep; }
#undef SV_LOAD
    }
    __syncthreads();
}

__device__ __forceinline__ void gdn_scan_unit(Ctx& C, int unit) {
    const int vs = unit & 1, dir = (unit >> 1) & 1, h = (unit >> 2) & 3, sq = unit >> 4;
    int tid_ = threadIdx.x; asm volatile("" : "+v"(tid_));
    const int tid = tid_, lane = tid & 63, wv = __builtin_amdgcn_readfirstlane(tid >> 6), r32 = lane & 31, hi = lane >> 5;
    bf16* Wc = (bf16*)C.lds; bf16* Qc = Wc + 64 * 136; bf16* KTc = Qc + 64 * 136; bf16* ATTc = KTc + 128 * 72; bf16* Uc = ATTc + 64 * 72;
    bf16* ST = Uc + 64 * 72; bf16* VNT = ST + 64 * 136; bf16* VN2T = VNT + 64 * 72; float* bv = (float*)(VN2T + 64 * 72); float* ebv = bv + 64; float* e2 = ebv + 64;
    const bf16* Wg = (const bf16*)(C.ws + WS_W) + (size_t)dir * HBR * 512; const bf16* Ug = (const bf16*)(C.ws + WS_U) + (size_t)dir * 1024 * 128 * 64;
    const bf16* Qg = (const bf16*)(C.ws + WS_QN); const bf16* KTg = (const bf16*)(C.ws + WS_KT); const bf16* ATg = (const bf16*)(C.ws + WS_ATT) + (size_t)dir * 1024 * 4096;
    const float* GBg = (const float*)(C.ws + WS_GB) + (size_t)dir * 1024 * 64;
    bf16* og = (bf16*)(C.ws + WS_OGDN) + (size_t)dir * HBR * 512 + h * 128 + vs * 64;
    struct Pre { u32x4 pw0, pw1, pq0, pq1, pk0, pk1, pa, pu; float pb; };
    Pre PA, PB; PA.pb = 0.f; PB.pb = 0.f;
    const int li = tid >> 3, lc = (tid & 7) * 8;
    auto issue = [&](int n, Pre& P) {
        const int cn = dir ? 127 - n : n, uidx = (sq * 4 + h) * 128 + cn; const size_t row = (size_t)sq * SEQ + cn * 64 + (dir ? 63 - li : li);
        const bf16* wp = Wg + row * 512 + h * 128 + lc; P.pw0 = *(const u32x4*)wp; P.pw1 = *(const u32x4*)(wp + 64);
        const bf16* qp = Qg + row * 512 + h * 128 + lc; P.pq0 = *(const u32x4*)qp; P.pq1 = *(const u32x4*)(qp + 64);
        const bf16* kp = KTg + ((size_t)uidx * 128 + (tid >> 2)) * 64 + (tid & 3) * 16; P.pk0 = *(const u32x4*)kp; P.pk1 = *(const u32x4*)(kp + 8);
        P.pa = *(const u32x4*)(ATg + ((size_t)uidx * 64 + li) * 64 + lc);
        P.pu = *(const u32x4*)(Ug + (((size_t)uidx * 128 + vs * 64 + li) * 64 + lc));
        if (tid < 64) P.pb = GBg[(size_t)uidx * 64 + tid];
    };
    auto commit = [&](const Pre& P) {
        *(u32x4*)(Wc + li * 136 + lc) = P.pw0; *(u32x4*)(Wc + li * 136 + 64 + lc) = P.pw1; *(u32x4*)(Qc + li * 136 + lc) = P.pq0; *(u32x4*)(Qc + li * 136 + 64 + lc) = P.pq1;
        *(u32x4*)(KTc + (tid >> 2) * 72 + (tid & 3) * 16) = P.pk0; *(u32x4*)(KTc + (tid >> 2) * 72 + (tid & 3) * 16 + 8) = P.pk1;
        *(u32x4*)(ATTc + li * 72 + lc) = P.pa; *(u32x4*)(Uc + li * 72 + lc) = P.pu;
        if (tid < 64) { const float pb = P.pb; bv[tid] = pb; ebv[tid] = __expf(pb); const float b63 = __shfl(pb, 63); e2[tid] = __expf(b63 - pb); }
    };
    float z0 = 0.f; asm volatile("" : "+v"(z0));
    ck::f32x16 S0 = ck::zero16(), S1 = ck::zero16();
    const int sel = wv >> 2, ti = (wv >> 1) & 1, tv = wv & 1, td = wv & 3;
    __syncthreads();
    for (int i = tid; i < 64 * 136 / 2; i += NTHREADS) ((unsigned*)ST)[i] = 0u;
    issue(0, PA); issue(1, PB); commit(PA);
    __syncthreads();
#pragma unroll 2
    for (int n = 0; n < 128; ++n) {
        if (n + 2 < 128) { if (n & 1) issue(n + 2, PB); else issue(n + 2, PA); }
        ck::f32x16 acc = ck::zero16();
        ck::mma<8>(acc, (sel ? Qc : Wc) + (32 * ti + r32) * 136 + 8 * hi, ST + (32 * tv + r32) * 136 + 8 * hi);
        if (sel == 0) {
#pragma unroll
            for (int g = 0; g < 4; ++g) { float vn[4], v2[4];
                const int ip0 = 32 * ti + 8 * g + 4 * hi; const u32x2 uu = *(const u32x2*)(Uc + (32 * tv + r32) * 72 + ip0); const f32x4 ee = *(const f32x4*)(e2 + ip0);
                vn[0] = bflo(uu.x) - acc[4 * g]; vn[1] = bfhi(uu.x) - acc[4 * g + 1]; vn[2] = bflo(uu.y) - acc[4 * g + 2]; vn[3] = bfhi(uu.y) - acc[4 * g + 3];
                v2[0] = vn[0] * ee.x; v2[1] = vn[1] * ee.y; v2[2] = vn[2] * ee.z; v2[3] = vn[3] * ee.w;
                u32x2 w; w.x = cvtpk(vn[0], vn[1]); w.y = cvtpk(vn[2], vn[3]); *(u32x2*)(VNT + (32 * tv + r32) * 72 + ip0) = w;
                u32x2 w2; if (dir) { w2.x = cvtpk(v2[3], v2[2]); w2.y = cvtpk(v2[1], v2[0]); *(u32x2*)(VN2T + (32 * tv + r32) * 72 + 60 - ip0) = w2; }
                else { w2.x = cvtpk(v2[0], v2[1]); w2.y = cvtpk(v2[2], v2[3]); *(u32x2*)(VN2T + (32 * tv + r32) * 72 + ip0) = w2; } } }
        __syncthreads();
        if (sel == 1) { ck::f32x16 a2 = ck::zero16(); ck::mma<4>(a2, ATTc + (32 * ti + r32) * 72 + 8 * hi, VNT + (32 * tv + r32) * 72 + 8 * hi);
            const int cn = dir ? 127 - n : n;
#pragma unroll
            for (int idx = 0; idx < 16; ++idx) { const int ip = 32 * ti + ck::crow(idx, hi); const size_t row = (size_t)sq * SEQ + cn * 64 + (dir ? 63 - ip : ip);
                og[row * 512 + 32 * tv + r32] = f2bf(ebv[ip] * acc[idx] + a2[idx]); } }
        if (sel == 0) { const float dec = ebv[63];
#pragma unroll
            for (int idx = 0; idx < 16; ++idx) { S0[idx] *= dec; S1[idx] *= dec; }
#pragma unroll
            for (int s = 0; s < 4; ++s) { const ck::bf16x8 ka = *(const ck::bf16x8*)(KTc + (32 * td + r32) * 72 + 8 * hi + 16 * s);
                S0 = __builtin_amdgcn_mfma_f32_32x32x16_bf16(ka, *(const ck::bf16x8*)(VN2T + r32 * 72 + 8 * hi + 16 * s), S0, 0, 0, 0);
                S1 = __builtin_amdgcn_mfma_f32_32x32x16_bf16(ka, *(const ck::bf16x8*)(VN2T + (32 + r32) * 72 + 8 * hi + 16 * s), S1, 0, 0, 0); }
#pragma unroll
            for (int g = 0; g < 4; ++g) { u32x2 w; w.x = cvtpk(S0[4 * g] + z0, S0[4 * g + 1] + z0); w.y = cvtpk(S0[4 * g + 2] + z0, S0[4 * g + 3] + z0); *(u32x2*)(ST + r32 * 136 + 32 * td + 8 * g + 4 * hi) = w;
                u32x2 w1; w1.x = cvtpk(S1[4 * g] + z0, S1[4 * g + 1] + z0); w1.y = cvtpk(S1[4 * g + 2] + z0, S1[4 * g + 3] + z0); *(u32x2*)(ST + (32 + r32) * 136 + 32 * td + 8 * g + 4 * hi) = w1; } }
        __syncthreads();
        if (n + 1 < 128) { if (n & 1) commit(PA); else commit(PB); }
        __syncthreads();
    }
}

__device__ __forceinline__ void gla_prep_setup(Ctx& C, int l) {
    float* up2 = (float*)(C.lds + 116224);
    __syncthreads();
    for (int i = C.tid; i < 2 * 2176; i += NTHREADS) { const int hs = i / 2176, r = i % 2176, h = (((C.wg >> 7) & 3) + 2 * hs) & 3;
        up2[i] = (r < 2048) ? C.in[IN_GLA_UP][((size_t)(l * 2 + (r >> 10)) * 16 + ((r >> 6) & 15)) * 256 + h * 64 + (r & 63)]
                            : C.in[IN_GLA_BIAS][(l * 2 + ((r - 2048) >> 6)) * 256 + h * 64 + (r & 63)]; }
    __syncthreads();
}
__device__ __forceinline__ void gla_prep_unit(Ctx& C, int uidx, int l, int hb) {
    const int cn = uidx & 127, h = (uidx >> 7) & 3, sq = uidx >> 9;
    int tid_ = threadIdx.x; asm volatile("" : "+v"(tid_));
    const int tid = tid_, dir = tid >> 8, t = tid & 255, lane = tid & 63, wv = __builtin_amdgcn_readfirstlane(tid >> 6), r32 = lane & 31, hi = lane >> 5;
    float* gB = (float*)C.lds + 2176; float* tot = gB + 8192;
    const int hs = ((h - (C.wg >> 7)) & 3) >> 1; const float* up = (const float*)(C.lds + 116224) + hs * 2176; const float* bs = up + 2048;
    bf16* Qr = (bf16*)(tot + 512); bf16* Kr = Qr + 64 * 72; bf16* Vr = Kr + 64 * 72; bf16* QD = Vr + 64 * 136; bf16* KD = QD + 2 * 64 * 72;
    const bf16* proj = (const bf16*)(C.ws + WS_PROJ) + (size_t)sq * SEQ * LDP;
    unsigned char* hfree = C.ws + WS_H + (size_t)hb * HBR * DM * 2;
    bf16* AMg = (bf16*)(C.ws + WS_GAM); bf16* KETg = (bf16*)(C.ws + WS_GKET); bf16* QEg = (bf16*)hfree; bf16* VTg = (bf16*)(hfree + 16 * MiB); float* DECg = (float*)(C.ws + WS_GDEC);
    __syncthreads();
    { const int lr = tid >> 3, lc = (tid & 7) * 8, vc = (tid & 7) * 16; const bf16* p = proj + (size_t)(cn * 64 + lr) * LDP;
        *(u32x4*)(Qr + lr * 72 + lc) = *(const u32x4*)(p + C_GQ + h * 64 + lc); *(u32x4*)(Kr + lr * 72 + lc) = *(const u32x4*)(p + C_GK + h * 64 + lc);
        *(u32x4*)(Vr + lr * 136 + vc) = *(const u32x4*)(p + C_GV + h * 128 + vc); *(u32x4*)(Vr + lr * 136 + vc + 8) = *(const u32x4*)(p + C_GV + h * 128 + vc + 8); }
    __syncthreads();
    { const int lr = t >> 2, lc = (t & 3) * 16, row = cn * 64 + (dir ? 63 - lr : lr); const bf16* p = proj + (size_t)row * LDP + (dir ? C_GWB : C_GWF);
        float g[16]; unpack8(*(const u32x4*)p, g); unpack8(*(const u32x4*)(p + 8), g + 8);
        const float* upd = up + dir * 1024;
#pragma unroll
        for (int i = 0; i < 16; ++i) { float z = bs[dir * 64 + lc + i];
#pragma unroll
            for (int r = 0; r < 16; ++r) z += g[r] * upd[r * 64 + lc + i];
            gB[(dir * 64 + lr) * 64 + lc + i] = ((z < 0.f ? z : 0.f) - __logf(1.0f + __expf(-fabsf(z)))) * 0.0625f; } }
    __syncthreads();
    { const int d = t & 63, seg = t >> 6; float s = 0.f;
#pragma unroll
        for (int q = 0; q < 16; ++q) { float* e = gB + (dir * 64 + seg * 16 + q) * 64 + d; s += *e; *e = s; }
        tot[(dir * 4 + seg) * 64 + d] = s; }
    __syncthreads();
    { const int lr = t >> 2, lc = (t & 3) * 16, seg = lr >> 4;
#pragma unroll
        for (int q4 = 0; q4 < 4; ++q4) { float* e = gB + (dir * 64 + lr) * 64 + lc + 4 * q4; f32x4 v = *(const f32x4*)e;
            for (int s = 0; s < seg; ++s) { const f32x4 tt = *(const f32x4*)(tot + (dir * 4 + s) * 64 + lc + 4 * q4); v += tt; }
            *(f32x4*)e = v; } }
    __syncthreads();
    { const int v = tid & 127, jb = tid >> 7; float x[16];
#pragma unroll
        for (int jj = 0; jj < 16; ++jj) x[jj] = bf2f(Vr[(jb * 16 + jj) * 136 + v]);
        bf16* o = VTg + ((size_t)uidx * 128 + v) * 64 + jb * 16; *(u32x4*)o = pack8(x); *(u32x4*)(o + 8) = pack8(x + 8); }
    if (t < 64) DECg[((size_t)dir * 1024 + uidx) * 64 + t] = __expf(gB[(dir * 64 + 63) * 64 + t]);
    { const int d = t & 63, jb = t >> 6; const float blast = gB[(dir * 64 + 63) * 64 + d]; float x[16];
#pragma unroll
        for (int jj = 0; jj < 16; ++jj) { const int jp = jb * 16 + jj, js = dir ? 63 - jp : jp; x[dir ? 15 - jj : jj] = bf2f(Kr[js * 72 + d]) * __expf(blast - gB[(dir * 64 + jp) * 64 + d]); }
        bf16* o = KETg + (((size_t)dir * 1024 + uidx) * 64 + d) * 64 + (dir ? 48 - jb * 16 : jb * 16); *(u32x4*)o = pack8(x); *(u32x4*)(o + 8) = pack8(x + 8); }
    { const int lr = t >> 2, lc = (t & 3) * 16, is = dir ? 63 - lr : lr; float xq[16], xk[16], qd[16], kd[16], qe[16];
        unpack8(*(const u32x4*)(Qr + is * 72 + lc), xq); unpack8(*(const u32x4*)(Qr + is * 72 + lc + 8), xq + 8); unpack8(*(const u32x4*)(Kr + is * 72 + lc), xk); unpack8(*(const u32x4*)(Kr + is * 72 + lc + 8), xk + 8);
#pragma unroll
        for (int i = 0; i < 16; ++i) { const float b = gB[(dir * 64 + lr) * 64 + lc + i], bmid = gB[(dir * 64 + 31) * 64 + lc + i];
            qd[i] = xq[i] * 0.125f * __expf(b - bmid); kd[i] = xk[i] * __expf(bmid - b); qe[i] = xq[i] * 0.125f * __expf(b); }
        bf16* qdp = QD + (dir * 64 + lr) * 72 + lc; *(u32x4*)qdp = pack8(qd); *(u32x4*)(qdp + 8) = pack8(qd + 8);
        bf16* kdp = KD + (dir * 64 + lr) * 72 + lc; *(u32x4*)kdp = pack8(kd); *(u32x4*)(kdp + 8) = pack8(kd + 8);
        bf16* o = QEg + (((size_t)dir * 1024 + uidx) * 64 + lr) * 64 + lc; *(u32x4*)o = pack8(qe); *(u32x4*)(o + 8) = pack8(qe + 8); }
    __syncthreads();
    { const int dw = wv >> 2, ti = (wv >> 1) & 1, tj = wv & 1; ck::f32x16 acc = ck::zero16();
        ck::mma<4>(acc, KD + (dw * 64 + 32 * tj + r32) * 72 + 8 * hi, QD + (dw * 64 + 32 * ti + r32) * 72 + 8 * hi);
        const int ip = 32 * ti + r32; bf16* o = AMg + (((size_t)dw * 1024 + uidx) * 64 + ip) * 64;
#pragma unroll
        for (int g = 0; g < 4; ++g) { const int j0 = 32 * tj + 8 * g + 4 * hi; float a[4];
#pragma unroll
            for (int q = 0; q < 4; ++q) a[q] = (j0 + q <= ip) ? acc[4 * g + q] : 0.f;
            u32x2 w; if (dw) { w.x = cvtpk(a[3], a[2]); w.y = cvtpk(a[1], a[0]); *(u32x2*)(o + 60 - j0) = w; } else { w.x = cvtpk(a[0], a[1]); w.y = cvtpk(a[2], a[3]); *(u32x2*)(o + j0) = w; } } }
}

__device__ __forceinline__ void gla_chunk_unit(Ctx& C, int unit, int l, int hb) {
    const int dir = unit & 1, h = (unit >> 1) & 3, sq = unit >> 3;
    int tid_ = threadIdx.x; asm volatile("" : "+v"(tid_));
    const int tid = tid_, lane = tid & 63, wv = __builtin_amdgcn_readfirstlane(tid >> 6), r32 = lane & 31, hi = lane >> 5;
    float* dl = (float*)C.lds;
    bf16* QE = (bf16*)(dl + 64); bf16* KET = QE + 64 * 72; bf16* VT = KET + 64 * 72; bf16* AM = VT + 128 * 72;
    bf16* ST0 = AM + 64 * 72;
    unsigned char* hfree = C.ws + WS_H + (size_t)hb * HBR * DM * 2;
    const bf16* AMg = (const bf16*)(C.ws + WS_GAM) + (size_t)dir * 1024 * 4096; const bf16* KETg = (const bf16*)(C.ws + WS_GKET) + (size_t)dir * 1024 * 4096;
    const bf16* QEg = (const bf16*)hfree + (size_t)dir * 1024 * 4096; const bf16* VTg = (const bf16*)(hfree + 16 * MiB); const float* DECg = (const float*)(C.ws + WS_GDEC) + (size_t)dir * 1024 * 64;
    bf16* og = (bf16*)(C.ws + WS_OGLA) + ((size_t)dir * HBR + (size_t)sq * SEQ) * 512 + h * 128;
    __syncthreads();
    for (int i = tid; i < 128 * 72 / 2; i += NTHREADS) ((unsigned*)ST0)[i] = 0u;
    const int lr = tid >> 3, lc = (tid & 7) * 8;
    u32x4 rqe, rke, ram, rv0, rv1; float rd = 0.f;
    auto issue = [&](int n) {
        const int cn = dir ? 127 - n : n; const size_t ub = (size_t)((sq * 4 + h) * 128 + cn);
        rqe = *(const u32x4*)(QEg + (ub * 64 + lr) * 64 + lc); rke = *(const u32x4*)(KETg + (ub * 64 + lr) * 64 + lc); ram = *(const u32x4*)(AMg + (ub * 64 + lr) * 64 + lc);
        rv0 = *(const u32x4*)(VTg + (ub * 128 + lr) * 64 + lc); rv1 = *(const u32x4*)(VTg + (ub * 128 + 64 + lr) * 64 + lc);
        if (tid < 64) rd = DECg[ub * 64 + tid];
    };
    float z0 = 0.f; asm volatile("" : "+v"(z0));
    ck::f32x16 S = ck::zero16();
    const int t2 = wv >> 2, tv = wv & 3;
    issue(0);
    for (int n = 0; n < 128; ++n) {
        *(u32x4*)(QE + lr * 72 + lc) = rqe; *(u32x4*)(KET + lr * 72 + lc) = rke; *(u32x4*)(AM + lr * 72 + lc) = ram; *(u32x4*)(VT + lr * 72 + lc) = rv0; *(u32x4*)(VT + (64 + lr) * 72 + lc) = rv1;
        if (tid < 64) dl[tid] = rd;
        __syncthreads();
        if (n + 1 < 128) issue(n + 1);
        const bf16* STc = ST0 + (n & 1) * 128 * 72; bf16* STn = ST0 + ((n + 1) & 1) * 128 * 72;
        { ck::f32x16 o = ck::zero16();
            ck::mma<4>(o, AM + (32 * t2 + r32) * 72 + 8 * hi, VT + (32 * tv + r32) * 72 + 8 * hi);
            ck::mma<4>(o, QE + (32 * t2 + r32) * 72 + 8 * hi, STc + (32 * tv + r32) * 72 + 8 * hi);
            const int cn = dir ? 127 - n : n;
#pragma unroll
            for (int idx = 0; idx < 16; ++idx) { const int ip = 32 * t2 + ck::crow(idx, hi); const size_t row = (size_t)cn * 64 + (dir ? 63 - ip : ip);
                og[row * 512 + 32 * tv + r32] = f2bf(o[idx] + z0); } }
        {
#pragma unroll
            for (int idx = 0; idx < 16; ++idx) S[idx] *= dl[32 * t2 + ck::crow(idx, hi)];
            ck::mma<4>(S, KET + (32 * t2 + r32) * 72 + 8 * hi, VT + (32 * tv + r32) * 72 + 8 * hi);
#pragma unroll
            for (int g = 0; g < 4; ++g) { u32x2 w; w.x = cvtpk(S[4 * g] + z0, S[4 * g + 1] + z0); w.y = cvtpk(S[4 * g + 2] + z0, S[4 * g + 3] + z0); *(u32x2*)(STn + (32 * tv + r32) * 72 + 32 * t2 + 8 * g + 4 * hi) = w; } }
        __syncthreads();
    }
}

__device__ __forceinline__ void finalize2_item(Ctx& C, int l, int item) {
    const bf16* proj = (const bf16*)(C.ws + WS_PROJ); bf16* ys = (bf16*)(C.ws + WS_YS);
    int tid_ = threadIdx.x; asm volatile("" : "+v"(tid_));
    const int tpw = 4, gw = item * NWAVES + __builtin_amdgcn_readfirstlane(tid_ >> 6), lane = tid_ & 63, c0 = lane * 8;
    for (int tk = 0; tk < tpw; ++tk) { const int r = gw * tpw + tk;
#pragma unroll
        for (int br = 0; br < 2; ++br) {
            const bf16* of = (const bf16*)(C.ws + (br == 0 ? WS_OGLA : WS_OGDN)) + (size_t)r * 512 + c0; const bf16* ob = of + (size_t)HBR * 512;
            const float* nw = C.in[br == 0 ? IN_GLA_NORM : IN_GDN_NORM] + l * 128 + (c0 & 127);
            float a[8], b[8], o[8]; unpack8(*(const u32x4*)of, a); unpack8(*(const u32x4*)ob, b);
            float ss = 0.f;
#pragma unroll
            for (int i = 0; i < 8; ++i) { o[i] = a[i] + b[i]; ss += o[i] * o[i]; }
            const float rs = rsqrtf(grp16_sum(ss) * (1.0f / 128.0f) + EPS);
            const u32x4 gw_ = *(const u32x4*)(proj + (size_t)r * LDP + (br == 0 ? C_GR : C_NZ) + c0); float gz[8]; unpack8(gw_, gz);
            float yv[8];
#pragma unroll
            for (int i = 0; i < 8; ++i) yv[i] = o[i] * rs * nw[i] * siluf_(gz[i]);
            *(u32x4*)(ys + ((size_t)(br == 0 ? 0 : 2) * HBR + r) * 512 + c0) = pack8(yv);
        }
    }
}

namespace att {
using bf16x8 = __attribute__((ext_vector_type(8))) short;
using s16x4  = __attribute__((ext_vector_type(4))) short;
using f32x16 = __attribute__((ext_vector_type(16))) float;
constexpr int KVBLK = 64;
constexpr float SCALE = 0.125f, THR = 8.f;
constexpr int SHM_V = KVBLK * 128 * 2, SHM_K = KVBLK * 128 * 2;
#define KSWZ(row, colB) ((row) * 256 + ((colB) ^ (((row) & 7) << 4)))
#define SBAR() __builtin_amdgcn_sched_barrier(0)
__device__ __forceinline__ int crow(int r, int hi) { return (r & 3) + 8 * (r >> 2) + 4 * hi; }
__device__ __forceinline__ void partialSM(f32x16& p0, f32x16& p1, float& m_reg, float& mn, float& alpha) {
  constexpr float Cc = SCALE * 1.4426950408889634f;
  float pmax = p0[0]; for (int r = 1; r < 16; ++r) pmax = fmaxf(pmax, p0[r]); for (int r = 0; r < 16; ++r) pmax = fmaxf(pmax, p1[r]);
  { auto rr = __builtin_amdgcn_permlane32_swap(__float_as_uint(pmax), __float_as_uint(pmax), false, false);
    pmax = fmaxf(__uint_as_float(rr[0]), __uint_as_float(rr[1])); }
  if (__builtin_expect(__all(pmax - m_reg <= THR / SCALE), 1)) { mn = m_reg; alpha = 1.f; }
  else { mn = fmaxf(m_reg, pmax); alpha = __builtin_amdgcn_exp2f((m_reg - mn) * Cc); m_reg = mn; }
  float mnC = -mn * Cc;
  for (int r = 0; r < 16; ++r) p0[r] = fmaf(p0[r], Cc, mnC); for (int r = 0; r < 16; ++r) p1[r] = fmaf(p1[r], Cc, mnC);
  for (int r = 0; r < 16; ++r) p0[r] = __builtin_amdgcn_exp2f(p0[r]);
}
__device__ __forceinline__ void finishSM(f32x16& p0, f32x16& p1, bf16x8& pa0, bf16x8& pa1, bf16x8& pa2, bf16x8& pa3) {
  for (int r = 0; r < 16; ++r) p1[r] = __builtin_amdgcn_exp2f(p1[r]);
#define PK4(P, BASE, OUT) do { unsigned a0 = cvtpk(P[BASE + 0], P[BASE + 1]), a1 = cvtpk(P[BASE + 2], P[BASE + 3]);   \
    unsigned b0 = cvtpk(P[BASE + 4], P[BASE + 5]), b1 = cvtpk(P[BASE + 6], P[BASE + 7]);                              \
    auto r0 = __builtin_amdgcn_permlane32_swap(a0, b0, false, false); auto r1 = __builtin_amdgcn_permlane32_swap(a1, b1, false, false); \
    u32x4 w = {r0[0], r1[0], r0[1], r1[1]}; OUT = *reinterpret_cast<bf16x8*>(&w); } while (0)
  PK4(p0, 0, pa0); PK4(p0, 8, pa1); PK4(p1, 0, pa2); PK4(p1, 8, pa3);
#undef PK4
}
__device__ __forceinline__ void qkt(f32x16& p0, f32x16& p1, const char* Ks, const bf16x8* qr, int r32, int hi, int s) {
  p0 = f32x16{}; p1 = f32x16{};
#pragma unroll
  for (int d0 = 0; d0 < 4; ++d0) { int cb = ((4 * s + d0) * 16 + hi * 8) * 2;
    bf16x8 b0 = *reinterpret_cast<const bf16x8*>(Ks + KSWZ(r32, cb));
    bf16x8 b1 = *reinterpret_cast<const bf16x8*>(Ks + KSWZ(32 + r32, cb));
    p0 = __builtin_amdgcn_mfma_f32_32x32x16_bf16(b0, qr[d0], p0, 0, 0, 0);
    p1 = __builtin_amdgcn_mfma_f32_32x32x16_bf16(b1, qr[d0], p1, 0, 0, 0); }
}
__device__ __forceinline__ int v_st(int k, int c) { const int kk = (k & ~0xC) | ((k & 4) << 1) | ((k & 8) >> 1); return ((kk >> 3) * 4 + (c >> 5)) * 512 + ((kk & 7) * 32 + (c & 31)) * 2; }
__device__ __forceinline__ int v_rd_base(int lane) { return ((lane & 3) << 3) | (((lane >> 2) & 3) << 6) | (((lane >> 4) & 1) << 5) | (((lane >> 5) & 1) << 8); }
constexpr int v_rd_off(int d0, int ks, int half) { return d0 * 512 + ks * 4096 + half * 2048; }
template <int OFF> __device__ __forceinline__ s16x4 tr_read(int vb) {
  s16x4 r; asm volatile("ds_read_b64_tr_b16 %0, %1 offset:%2" : "=&v"(r) : "v"(vb), "i"(OFF) : "memory"); return r;
}
template <int D0> __device__ __forceinline__ void pv_one(f32x16& od, int vb, bf16x8 pa0, bf16x8 pa1, bf16x8 pa2, bf16x8 pa3) {
  const s16x4 l0 = tr_read<v_rd_off(D0, 0, 0)>(vb), h0 = tr_read<v_rd_off(D0, 0, 1)>(vb), l1 = tr_read<v_rd_off(D0, 1, 0)>(vb), h1 = tr_read<v_rd_off(D0, 1, 1)>(vb);
  const s16x4 l2 = tr_read<v_rd_off(D0, 2, 0)>(vb), h2 = tr_read<v_rd_off(D0, 2, 1)>(vb), l3 = tr_read<v_rd_off(D0, 3, 0)>(vb), h3 = tr_read<v_rd_off(D0, 3, 1)>(vb);
  asm volatile("s_waitcnt lgkmcnt(0)" ::: "memory"); SBAR();
#define PK(Lo, Hi) (bf16x8){Lo[0], Lo[1], Lo[2], Lo[3], Hi[0], Hi[1], Hi[2], Hi[3]}
  od = __builtin_amdgcn_mfma_f32_32x32x16_bf16(pa0, PK(l0, h0), od, 0, 0, 0);
  od = __builtin_amdgcn_mfma_f32_32x32x16_bf16(pa1, PK(l1, h1), od, 0, 0, 0);
  od = __builtin_amdgcn_mfma_f32_32x32x16_bf16(pa2, PK(l2, h2), od, 0, 0, 0);
  od = __builtin_amdgcn_mfma_f32_32x32x16_bf16(pa3, PK(l3, h3), od, 0, 0, 0);
#undef PK
}
__device__ __forceinline__ void pv_d0(f32x16* o, f32x16& lacc, int vb, bf16x8 pa0, bf16x8 pa1, bf16x8 pa2, bf16x8 pa3) {
  { const bf16x8 ones = {0x3F80, 0x3F80, 0x3F80, 0x3F80, 0x3F80, 0x3F80, 0x3F80, 0x3F80};
    lacc = __builtin_amdgcn_mfma_f32_32x32x16_bf16(pa0, ones, lacc, 0, 0, 0); lacc = __builtin_amdgcn_mfma_f32_32x32x16_bf16(pa1, ones, lacc, 0, 0, 0);
    lacc = __builtin_amdgcn_mfma_f32_32x32x16_bf16(pa2, ones, lacc, 0, 0, 0); lacc = __builtin_amdgcn_mfma_f32_32x32x16_bf16(pa3, ones, lacc, 0, 0, 0); }
  pv_one<0>(o[0], vb, pa0, pa1, pa2, pa3); pv_one<1>(o[1], vb, pa0, pa1, pa2, pa3); pv_one<2>(o[2], vb, pa0, pa1, pa2, pa3); pv_one<3>(o[3], vb, pa0, pa1, pa2, pa3);
}

__device__ __forceinline__ void attn_unit(const bf16* __restrict__ Qb, const bf16* __restrict__ Kh, const bf16* __restrict__ Vh, bf16* __restrict__ Yb,
                                          float lam, const float* gl, char* lds, int NTr, float* pq, int myq, unsigned* uctr) {
  int tid_ = threadIdx.x; asm volatile("" : "+v"(tid_));
  const int tid = tid_, wid = __builtin_amdgcn_readfirstlane(tid >> 6), lane = tid & 63, r32 = lane & 31, hi = lane >> 5, s = wid >> 2, wq = wid & 3;
  char* V_lds = lds; char* K_lds = lds + 2 * SHM_V;
  float* ws = (float*)(lds + 2 * SHM_V + 2 * SHM_K) + wid * 64; float* li_l = ws; float* al_l = ws + 32;
  float m_reg = -1e30f; f32x16 o[4] = {}; f32x16 lacc = {}; bf16x8 qr[4];
  const bf16* Qw = Qb + (long)(wq * 32 + r32) * LDP + s * 64 + hi * 8;
#pragma unroll
  for (int d0 = 0; d0 < 4; ++d0) qr[d0] = *reinterpret_cast<const bf16x8*>(Qw + d0 * 16);
  const int sr = tid >> 4, sc = (tid & 15) * 8, vst0 = v_st(sr, sc), vst1 = v_st(32 + sr, sc);
  const int vb0 = (int)(uintptr_t)V_lds + v_rd_base(lane);
  struct { bf16x8 vs0, vs1, ks0, ks1; } sr_[2];
#define SLOAD(i, k0) do { sr_[i].vs0 = *reinterpret_cast<const bf16x8*>(&Vh[(long)((k0) + sr) * LDP + sc]); sr_[i].vs1 = *reinterpret_cast<const bf16x8*>(&Vh[(long)((k0) + 32 + sr) * LDP + sc]); \
    sr_[i].ks0 = *reinterpret_cast<const bf16x8*>(&Kh[(long)((k0) + sr) * LDP + sc]); sr_[i].ks1 = *reinterpret_cast<const bf16x8*>(&Kh[(long)((k0) + 32 + sr) * LDP + sc]); } while (0)
#define SWRITE(b, i) do { *(bf16x8*)(V_lds + (b) * SHM_V + vst0) = sr_[i].vs0;          \
    *(bf16x8*)(V_lds + (b) * SHM_V + vst1) = sr_[i].vs1; int kc = sc * 2;               \
    *(bf16x8*)(K_lds + (b) * SHM_K + KSWZ(sr, kc)) = sr_[i].ks0;                       \
    *(bf16x8*)(K_lds + (b) * SHM_K + KSWZ(32 + sr, kc)) = sr_[i].ks1; } while (0)
#define SWAIT() asm volatile("s_waitcnt vmcnt(4)" ::: "memory")
#define RESC(a) do { if (__any((a) < 1.f)) { if (hi == 0) al_l[r32] = (a); asm volatile("s_waitcnt lgkmcnt(0)" ::: "memory"); \
    for (int r = 0; r < 16; ++r) { const float a_ = al_l[crow(r, hi)]; lacc[r] *= a_; for (int d = 0; d < 4; ++d) o[d][r] *= a_; } } } while (0)
  f32x16 pA0, pA1, pB0, pB1; float mnA, mnB, alA, alB; bf16x8 pa0, pa1, pa2, pa3; const int NT = NTr;
  constexpr int SE = 0, SO = 1;
  SLOAD(SE, 0); asm volatile("s_waitcnt vmcnt(0)" ::: "memory"); SWRITE(0, SE); __syncthreads();
  qkt(pA0, pA1, K_lds, qr, r32, hi, s); partialSM(pA0, pA1, m_reg, mnA, alA);
  SLOAD(SO, KVBLK); SLOAD(SE, 2 * KVBLK);
  SWAIT(); SWRITE(1, SO); __syncthreads();
  for (int j = 1; j + 1 < NT; j += 2) {
    SBAR(); qkt(pB0, pB1, K_lds + SHM_K, qr, r32, hi, s);
    finishSM(pA0, pA1, pa0, pa1, pa2, pa3); SBAR();
    SLOAD(SO, (j + 2) * KVBLK); SBAR();
    pv_d0(o, lacc, vb0, pa0, pa1, pa2, pa3); partialSM(pB0, pB1, m_reg, mnB, alB);
    __syncthreads(); SWAIT(); SWRITE(0, SE);
    RESC(alB); __syncthreads();
    SBAR(); qkt(pA0, pA1, K_lds, qr, r32, hi, s);
    finishSM(pB0, pB1, pa0, pa1, pa2, pa3); SBAR();
    if (j + 3 < NT) SLOAD(SE, (j + 3) * KVBLK); SBAR();
    pv_d0(o, lacc, vb0 + (int)SHM_V, pa0, pa1, pa2, pa3); partialSM(pA0, pA1, m_reg, mnA, alA);
    __syncthreads(); SWAIT(); SWRITE(1, SO);
    RESC(alA); __syncthreads();
  }
  SBAR(); qkt(pB0, pB1, K_lds + SHM_K, qr, r32, hi, s);
  finishSM(pA0, pA1, pa0, pa1, pa2, pa3); SBAR();
  pv_d0(o, lacc, vb0, pa0, pa1, pa2, pa3); partialSM(pB0, pB1, m_reg, mnB, alB);
  __syncthreads(); RESC(alB);
  finishSM(pB0, pB1, pa0, pa1, pa2, pa3); SBAR();
  pv_d0(o, lacc, vb0 + (int)SHM_V, pa0, pa1, pa2, pa3);
  if (pq != nullptr) {
    constexpr int ITEMF = 21 * 512 * 4;
    f32x4* pw = (f32x4*)pq + tid;
#pragma unroll
    for (int d0 = 0; d0 < 4; ++d0)
#pragma unroll
      for (int r4 = 0; r4 < 4; ++r4) pw[(d0 * 4 + r4) * 512] = (f32x4){o[d0][4 * r4], o[d0][4 * r4 + 1], o[d0][4 * r4 + 2], o[d0][4 * r4 + 3]};
#pragma unroll
    for (int r4 = 0; r4 < 4; ++r4) pw[(16 + r4) * 512] = (f32x4){lacc[4 * r4], lacc[4 * r4 + 1], lacc[4 * r4 + 2], lacc[4 * r4 + 3]};
    pw[20 * 512] = (f32x4){m_reg, 0.f, 0.f, 0.f};
    asm volatile("s_waitcnt vmcnt(0)" ::: "memory"); __syncthreads();
    volatile unsigned* bw = (volatile unsigned*)(lds + MISC_OFF) + 17;
    if (tid == 0) { __builtin_amdgcn_fence(__ATOMIC_RELEASE, "agent"); asm volatile("s_waitcnt vmcnt(0)" ::: "memory"); *bw = ::xb_add(uctr, 1u); }
    __syncthreads();
    const unsigned old_ = *bw;
    if (old_ != 3u) { __syncthreads(); return; }
    if (tid == 0) { __builtin_amdgcn_fence(__ATOMIC_ACQUIRE, "agent"); asm volatile("s_waitcnt vmcnt(0)" ::: "memory"); }
    __syncthreads();
    constexpr float Cc = SCALE * 1.4426950408889634f;
    { const f32x4* p0 = (const f32x4*)(pq - myq * ITEMF) + tid; const f32x4 ml0 = p0[20 * 512]; m_reg = ml0.x;
#pragma unroll
      for (int r4 = 0; r4 < 4; ++r4) { const f32x4 v = p0[(16 + r4) * 512]; lacc[4 * r4] = v.x; lacc[4 * r4 + 1] = v.y; lacc[4 * r4 + 2] = v.z; lacc[4 * r4 + 3] = v.w; }
#pragma unroll
      for (int d0 = 0; d0 < 4; ++d0)
#pragma unroll
        for (int r4 = 0; r4 < 4; ++r4) { const f32x4 v = p0[(d0 * 4 + r4) * 512]; o[d0][4 * r4] = v.x; o[d0][4 * r4 + 1] = v.y; o[d0][4 * r4 + 2] = v.z; o[d0][4 * r4 + 3] = v.w; } }
#pragma unroll 1
    for (int qq_ = 1; qq_ < 4; ++qq_) { int qq = qq_; asm volatile("" : "+s"(qq));
      const f32x4* pr = (const f32x4*)(pq + (qq - myq) * ITEMF) + tid;
      const f32x4 ml = pr[20 * 512]; const float mp = ml.x;
      const float mnw = fmaxf(m_reg, mp), ac = __builtin_amdgcn_exp2f((m_reg - mnw) * Cc), ap = __builtin_amdgcn_exp2f((mp - mnw) * Cc);
      m_reg = mnw;
      if (hi == 0) { al_l[r32] = ac; li_l[r32] = ap; } asm volatile("s_waitcnt lgkmcnt(0)" ::: "memory");
#pragma unroll
      for (int d0 = 0; d0 < 4; ++d0) { f32x4 v[4];
#pragma unroll
        for (int r4 = 0; r4 < 4; ++r4) v[r4] = pr[(d0 * 4 + r4) * 512];
#pragma unroll
        for (int r = 0; r < 16; ++r) o[d0][r] = o[d0][r] * al_l[crow(r, hi)] + v[r >> 2][r & 3] * li_l[crow(r, hi)]; }
      { f32x4 v[4];
#pragma unroll
        for (int r4 = 0; r4 < 4; ++r4) v[r4] = pr[(16 + r4) * 512];
#pragma unroll
        for (int r = 0; r < 16; ++r) lacc[r] = lacc[r] * al_l[crow(r, hi)] + v[r >> 2][r & 3] * li_l[crow(r, hi)]; }
    }
  }
  float rli[16];
#pragma unroll
  for (int r = 0; r < 16; ++r) rli[r] = __builtin_amdgcn_rcpf(lacc[r]);
  __syncthreads();
  int xb = (wq * 4096 + lane) * 4; asm volatile("" : "+v"(xb));
  float* X = (float*)(lds + xb);
  if (s == 1) {
#pragma unroll
    for (int d0 = 0; d0 < 4; ++d0)
#pragma unroll
      for (int r = 0; r < 16; ++r) X[(d0 * 16 + r) * 64] = o[d0][r] * rli[r];
  }
  __syncthreads();
  if (s == 0) {
    int yb = ((wq * 32 + 4 * hi) * 512 + r32) * 2; asm volatile("" : "+v"(yb));
    bf16* Yw = (bf16*)((char*)Yb + yb);
#pragma unroll
    for (int r = 0; r < 16; ++r) {
      float dv[4], t = 0.f;
#pragma unroll
      for (int d0 = 0; d0 < 4; ++d0) { dv[d0] = o[d0][r] * rli[r] - lam * X[(d0 * 16 + r) * 64]; t += dv[d0] * dv[d0]; }
      t = grp32_sum(t);
      const float rs = rsqrtf(t * (1.0f / 128.0f) + EPS);
#pragma unroll
      for (int d0 = 0; d0 < 4; ++d0) Yw[((r & 3) + 8 * (r >> 2)) * 512 + d0 * 32] = f2bf(dv[d0] * rs * gl[d0 * 32 + r32]);
    }
  }
  __syncthreads();
#undef SLOAD
#undef SWRITE
#undef SWAIT
#undef RESC
}
#undef KSWZ
#undef SBAR
}

__device__ __forceinline__ void attn_setup(Ctx& C, int l) {
  float* gl = (float*)(C.lds + 2 * att::SHM_V + 2 * att::SHM_K + NWAVES * 64 * 4);
  const float lam_init = 0.8f - 0.6f * __expf(-0.3f * (float)l);
  __syncthreads();
  if (C.tid < 128) gl[C.tid] = C.in[IN_DIFF_NORM][l * 128 + C.tid] * (1.0f - lam_init);
  if (C.tid == 128) gl[128] = ((const float*)(C.ws + WS_MODF))[49152 + l];
  __syncthreads();
}
__device__ __forceinline__ void attn_run_unit(Ctx& C, int u, int quarter, int kslot, float* pbuf, unsigned* uctr) {
  float* gl = (float*)(C.lds + 2 * att::SHM_V + 2 * att::SHM_K + NWAVES * 64 * 4);
  const float lam = gl[128];
  const bf16* proj = (const bf16*)(C.ws + WS_PROJ); bf16* ys = (bf16*)(C.ws + WS_YS) + (size_t)HBR * 512;
  const int qb = u & 63, h = (u >> 6) & 3, sq = u >> 8;
  const bf16* seqp = proj + (size_t)sq * SEQ * LDP;
  const size_t koff = quarter < 0 ? 0 : (size_t)quarter * 2048 * LDP;
  att::attn_unit(seqp + (size_t)(qb * 128) * LDP + C_DQ + 2 * h * 64, seqp + koff + C_DK + h * 128, seqp + koff + C_DV + h * 128,
                 ys + ((size_t)sq * SEQ + qb * 128) * 512 + h * 128, lam, gl, (char*)C.lds,
                 quarter < 0 ? SEQ / att::KVBLK : 32, quarter < 0 ? nullptr : pbuf + (size_t)(kslot * 4 + quarter) * (21 * 512 * 4), quarter, uctr + kslot);
}

__device__ __forceinline__ void phase_moe_prep(Ctx& C) {
    int* tot = (int*)(C.lds + 8 * 8704 + 4096); int* baseA = tot + 8; int* baseB = baseA + 8; int* off = baseB + 8;
    const int* gcnt = (const int*)(C.ws + WS_GCNT); const int* lpos = (const int*)(C.ws + WS_LPOS); const uint4* route = (const uint4*)(C.ws + WS_ROUTE);
    int* slotrow = (int*)(C.ws + WS_SLOTROW); int* tile_exp = (int*)(C.ws + WS_TILEEXP);
    const bf16* H = (const bf16*)(C.ws + WS_H); bf16* AS = (bf16*)(C.ws + WS_ASORT);
    __syncthreads();
    if (C.tid < 40) tot[C.tid] = 0;
    __syncthreads();
    { const int e = C.tid & 7, chunk = C.tid >> 3, gA = C.wg, gB = 256 + C.wg; int t = 0, a = 0, b = 0;
        for (int g = chunk * 8; g < chunk * 8 + 8; ++g) { const int c = gcnt[g * 8 + e]; t += c; if (g < gA) a += c; if (g < gB) b += c; }
        atomicAdd(&tot[e], t); atomicAdd(&baseA[e], a); atomicAdd(&baseB[e], b); }
    __syncthreads();
    if (C.tid == 0) { int o = 0; for (int e = 0; e < 8; ++e) { off[e] = o; o += (tot[e] + 255) & ~255; } off[8] = o; }
    __syncthreads();
    if (C.wg == 0 && C.tid < MOE_MAXT + 1) { if (C.tid == MOE_MAXT) tile_exp[MOE_MAXT] = off[8] >> 8;
        else { int e = 0; for (int q = 1; q < 8; ++q) if (C.tid * 256 >= off[q]) e = q; tile_exp[C.tid] = e; } }
    for (int hbi = 0; hbi < 2; ++hbi) { const int* base = hbi ? baseB : baseA;
        for (int i = C.wave; i < 64; i += NWAVES) { const int r = hbi * HBR + C.wg * 64 + i; const uint4 rt = route[r];
            const int row0 = off[rt.x] + base[rt.x] + lpos[2 * r], row1 = off[rt.y] + base[rt.y] + lpos[2 * r + 1];
            if (C.lane == 0) { slotrow[2 * r] = row0; slotrow[2 * r + 1] = row1; }
            const u32x4* src = (const u32x4*)(H + (size_t)r * DM) + C.lane; const u32x4 v0 = src[0], v1 = src[64];
            u32x4* d0 = (u32x4*)(AS + (size_t)row0 * DM) + C.lane; u32x4* d1 = (u32x4*)(AS + (size_t)row1 * DM) + C.lane;
            d0[0] = v0; d0[64] = v1; d1[0] = v0; d1[64] = v1; } }
    { const int gw = C.wg * NWAVES + C.wave;
        for (int e = 0; e < 8; ++e) { const int p0 = off[e] + tot[e], npad = off[e + 1] - p0;
            if (gw < npad) { u32x4* d = (u32x4*)(AS + (size_t)(p0 + gw) * DM) + C.lane; d[0] = (u32x4){0, 0, 0, 0}; d[64] = (u32x4){0, 0, 0, 0}; } } }
}

struct Args { const float* in[25]; float* out; unsigned char* ws; int ph_lo, ph_hi; };
constexpr int NPH = 37;

__global__ void __launch_bounds__(NTHREADS, 2) mk_fwd(Args args) {
    extern __shared__ __attribute__((aligned(16))) unsigned char lds[];
    Ctx C;
#pragma unroll
    for (int i = 0; i < 25; ++i) C.in[i] = args.in[i];
    C.out = args.out; C.ws = args.ws; C.lds = lds;
    C.tid = threadIdx.x; C.lane = C.tid & 63; C.wave = __builtin_amdgcn_readfirstlane(C.tid >> 6); C.wg = blockIdx.x; C.G = gridDim.x;
    LAS unsigned char* ldsl = (LAS unsigned char*)lds;
    volatile LAS unsigned* MISC = (volatile LAS unsigned*)(ldsl + MISC_OFF);
    if (C.tid < 64) MISC[C.tid] = 0u;
    __syncthreads();
    const int lo = args.ph_lo, hi = args.ph_hi;
    const bool multi = (hi - lo) > 1;
    XcdBarrier bar; bar.bar = (unsigned*)(C.ws + WS_CTL) + CW_BAR; bar.x = 0; bar.st = MISC + 8;
    if (multi) bar = xcd_barrier_post((unsigned*)(C.ws + WS_CTL) + CW_BAR, MISC + 8);
    int ph = 0;
#define ENTER() do { int t_ = threadIdx.x; asm volatile("" : "+v"(t_)); C.tid = t_; C.lane = t_ & 63; C.wave = __builtin_amdgcn_readfirstlane(t_ >> 6); } while (0)
#define RUN(k) ((k) >= lo && (k) < hi)
#define SEAM(k) do { if (RUN(k) && RUN((k) + 1)) xcd_barrier(bar); } while (0)

    bf16* H = (bf16*)(C.ws + WS_H); bf16* PROJ = (bf16*)(C.ws + WS_PROJ);

    if (RUN(ph)) { ENTER(); mod_partials(C); __syncthreads(); int base = 0; convert_mixer_weights(C, 0, base); convert_ffn_weights(C, base); }
    SEAM(ph); ++ph;
    if (RUN(ph)) { ENTER(); phase_norm_in(C, C.in[IN_X], 0); }
    SEAM(ph); ++ph;

    for (int l_ = 0; l_ < 2; ++l_) {
        int l = l_; asm volatile("" : "+s"(l));
        for (int hb_ = 0; hb_ < 2; ++hb_) {
            int hb = hb_; asm volatile("" : "+s"(hb));
            if (RUN(ph)) { ENTER(); pg8::Gemm g{H + (size_t)hb * HBR * DM, (const bf16*)(C.ws + WS_WIN), HBR, 8192, DM}; pg8::StaticOrder S; S.init(HBR, 8192, C.G, C.wg);
                pg8::EpiStoreBf16 E{PROJ, LDP, 0};
                pg8::gemm_phase<pg8::EpiStoreBf16, pg8::StaticOrder>(ldsl, g, S, E, nullptr);
                proj_tail_unit(C, hb); }
            SEAM(ph); ++ph;
            if (RUN(ph)) { ENTER();
                phase_rope(C, hb); gdn_prep_setup(C, l); for (int u = C.wg; u < 1024; u += C.G) gdn_prep_unit(C, u, l); gla_prep_setup(C, l); for (int u = C.wg; u < 1024; u += C.G) gla_prep_unit(C, u, l, hb); }
            SEAM(ph); ++ph;
            if (RUN(ph)) { ENTER();
                unsigned* qctr = (unsigned*)(C.ws + WS_CTL) + 1024 + 64 * (l * 2 + hb);
                unsigned* cdone = qctr + 32; bool gl_ok = false, ch_ok = false;
                for (;;) {
                    __syncthreads();
                    if (C.tid == 0) MISC[16] = atomicAdd(qctr, 1u);
                    __syncthreads();
                    const int item = (int)MISC[16];
                    if (item >= 704 + 512) break;
                    if (item >= 704) { if (!ch_ok) { if (C.tid == 0) { XB_SPIN(xb_ld(cdone) < 48u, bar.bar); __builtin_amdgcn_fence(__ATOMIC_ACQUIRE, "agent"); asm volatile("s_waitcnt vmcnt(0)" ::: "memory"); }
                            __syncthreads(); ch_ok = true; }
                        finalize2_item(C, l, item - 704); continue; }
                    if (item < 48) { if (item < 16) gla_chunk_unit(C, item, l, hb); else gdn_scan_unit(C, item - 16); gl_ok = false;
                        asm volatile("s_waitcnt vmcnt(0)" ::: "memory"); __syncthreads();
                        if (C.tid == 0) { __builtin_amdgcn_fence(__ATOMIC_RELEASE, "agent"); asm volatile("s_waitcnt vmcnt(0)" ::: "memory"); (void)xb_add(cdone, 1u); } }
                    else { if (!gl_ok) { attn_setup(C, l); gl_ok = true; }
                        float* pbuf = (l == 0) ? (float*)C.out + (size_t)16 * 1024 * 1024 : (float*)(C.ws + WS_W13);
                        unsigned* uctr = (unsigned*)(C.ws + WS_CTL) + 16384 + 64 * (l * 2 + hb);
                        if (item < 512) attn_run_unit(C, item - 48, -1, 0, pbuf, uctr);
                        else { const int q = item - 512; attn_run_unit(C, 464 + (q >> 2), q & 3, q >> 2, pbuf, uctr); } }
                }
            }
            SEAM(ph); ++ph;
            if (RUN(ph)) { ENTER(); pg8::Gemm g{(const bf16*)(C.ws + WS_YS), (const bf16*)(C.ws + WS_WB), 3 * HBR, 3 * DM, 512}; pg8::SchedMerge S{HBR / 256, C.G, C.wg};
                pg8::EpiMerge E{PROJ + C_MG, LDP, (bf16*)(C.ws + WS_MERGED), HBR / 256};
                pg8::gemm_phase<pg8::EpiMerge, pg8::SchedMerge>(ldsl, g, S, E, nullptr); }
            SEAM(ph); ++ph;
            if (RUN(ph)) { ENTER(); pg8::Gemm g{(const bf16*)(C.ws + WS_MERGED), (const bf16*)(C.ws + WS_WO), HBR, DM, DM}; pg8::StaticOrder S; S.init(HBR, DM, C.G, C.wg);
                pg8::EpiStoreBf16 E{(bf16*)(C.ws + WS_Y), DM, 0};
                pg8::gemm_phase<pg8::EpiStoreBf16, pg8::StaticOrder>(ldsl, g, S, E, nullptr); }
            SEAM(ph); ++ph;
            if (RUN(ph)) { ENTER(); phase_resnorm(C, hb * HBR, HBR, (l == 0) ? C.in[IN_X] : (const float*)C.out, (const float*)(C.ws + WS_Y), hb * HBR, false,
                                       l, 2, 1, true, l, 4, 3, 2, l == 1, hb * 256); }
            if (hb == 1) SEAM(ph);
            ++ph;
        }
        if (l == 0) {
            if (RUN(ph)) { ENTER(); pg8::Gemm g{H, (const bf16*)(C.ws + WS_W13), TOK, 2 * DFF, DM}; pg8::StaticOrder S; S.init(TOK, 2 * DFF, C.G, C.wg);
                pg8::EpiSwiGLU E{(bf16*)(C.ws + WS_HID), DFF, 0, 0};
                pg8::gemm_phase<pg8::EpiSwiGLU, pg8::StaticOrder>(ldsl, g, S, E, nullptr); }
            SEAM(ph); ++ph;
            if (RUN(ph)) { ENTER(); pg8::Gemm g{(const bf16*)(C.ws + WS_HID), (const bf16*)(C.ws + WS_W2), TOK, DM, DFF}; pg8::StaticOrder S; S.init(TOK, DM, C.G, C.wg);
                pg8::EpiStoreBf16 E{(bf16*)(C.ws + WS_Y2), DM, 0};
                pg8::gemm_phase<pg8::EpiStoreBf16, pg8::StaticOrder>(ldsl, g, S, E, nullptr); }
            SEAM(ph); ++ph;
            if (RUN(ph)) { ENTER(); phase_resnorm(C, 0, TOK, (const float*)C.out, (const float*)(C.ws + WS_Y2), 0, false, 0, 5, 3, true, 1, 1, 0, 0, false, 0);
                __syncthreads(); int base = 0; convert_mixer_weights(C, 1, base); }
            SEAM(ph); ++ph;
        } else {
            if (RUN(ph)) { ENTER(); phase_moe_prep(C); __syncthreads(); int base = 0; convert_moe_weights(C, base); }
            SEAM(ph); ++ph;
            const int* tile_exp = (const int*)(C.ws + WS_TILEEXP);
            for (int p_ = 0; p_ < MOE_NPASS; ++p_) {
                int p = p_; asm volatile("" : "+s"(p));
                if (RUN(ph)) { ENTER(); const int ntl = tile_exp[MOE_MAXT], t0 = p * MOE_PASS_T; int nt = ntl - t0; nt = nt < 0 ? 0 : (nt > MOE_PASS_T ? MOE_PASS_T : nt);
                    pg8::Gemm g{(const bf16*)(C.ws + WS_ASORT), (const bf16*)(C.ws + WS_MW13), 0, 0, DM}; pg8::SchedMoe1 S{tile_exp, t0, nt, C.G, C.wg};
                    pg8::EpiSwiGLU E{(bf16*)(C.ws + WS_MHID), DEXP, 1, t0};
                    pg8::gemm_phase<pg8::EpiSwiGLU, pg8::SchedMoe1>(ldsl, g, S, E, nullptr); }
                SEAM(ph); ++ph;
                if (RUN(ph)) { ENTER(); const int ntl = tile_exp[MOE_MAXT], t0 = p * MOE_PASS_T; int nt = ntl - t0; nt = nt < 0 ? 0 : (nt > MOE_PASS_T ? MOE_PASS_T : nt);
                    if (p < MOE_NPASS - 1) {
                    pg8::Gemm g{(const bf16*)(C.ws + WS_MHID), (const bf16*)(C.ws + WS_MW2), 0, 0, DEXP, 0}; pg8::SchedMoe2 S{tile_exp, t0, nt, C.G, C.wg};
                    pg8::EpiStoreBf16 E{(bf16*)(C.ws + WS_ASORT), DM, 1};
                    pg8::gemm_phase<pg8::EpiStoreBf16, pg8::SchedMoe2>(ldsl, g, S, E, nullptr);
                    } else {
                    pg8::Gemm g{(const bf16*)(C.ws + WS_MHID), (const bf16*)(C.ws + WS_MW2), 0, 0, DEXP / 4, DEXP}; pg8::SchedMoe2K S{tile_exp, t0, nt, C.G, C.wg};
                    pg8::EpiStoreBf16 E{(bf16*)(C.ws + WS_MPART), DM, 2};
                    pg8::gemm_phase<pg8::EpiStoreBf16, pg8::SchedMoe2K>(ldsl, g, S, E, nullptr); } }
                SEAM(ph); ++ph;
            }
            if (RUN(ph)) { ENTER(); phase_resnorm(C, 0, TOK, (const float*)C.out, nullptr, 0, true, 1, 5, 3, false, 1, 0, 0, 0, false, 0); }
            ++ph;
        }
    }
#undef RUN
#undef SEAM
}

extern "C" void kernel_launch(void* const* d_in, const int* in_sizes, int n_in, void* d_out, int out_size, void* d_ws, size_t ws_size, hipStream_t stream) {
    static int grid = 0;
    if (grid == 0) {
        if (n_in != 25 || out_size != TOK * DM || ws_size < WS_END) { fprintf(stderr, "kernel_launch: unexpected problem (n_in %d out %d ws %zu, need ws >= %zu)\n", n_in, out_size, ws_size, (size_t)WS_END); grid = -1; return; }
        int dev = 0, cus = 0, per_cu = 0;
        if (hipGetDevice(&dev) != hipSuccess || hipDeviceGetAttribute(&cus, hipDeviceAttributeMultiprocessorCount, dev) != hipSuccess) { grid = -1; return; }
        if (hipFuncSetAttribute((const void*)mk_fwd, hipFuncAttributeMaxDynamicSharedMemorySize, LDS_BYTES) != hipSuccess) { fprintf(stderr, "kernel_launch: hipFuncSetAttribute failed\n"); grid = -1; return; }
        if (hipOccupancyMaxActiveBlocksPerMultiprocessor(&per_cu, (const void*)mk_fwd, NTHREADS, LDS_BYTES) != hipSuccess || per_cu < 1) fprintf(stderr, "kernel_launch: occupancy query says %d\n", per_cu);
        (void)hipGetLastError();
        grid = cus;
        if (grid != 256) fprintf(stderr, "kernel_launch: %d CUs (built for 256)\n", grid);
    }
    if (grid < 0) return;
    (void)hipMemsetAsync((char*)d_ws + WS_CTL, 0, CTL_ZERO_BYTES, stream);
    Args a{};
    for (int i = 0; i < 25; ++i) a.in[i] = (const float*)d_in[i];
    a.out = (float*)d_out; a.ws = (unsigned char*)d_ws;
#if MK_ONE_LAUNCH
    a.ph_lo = 0; a.ph_hi = 1 << 20;
    hipLaunchKernelGGL(mk_fwd, dim3(grid), dim3(NTHREADS), LDS_BYTES, stream, a);
#else
    for (int p = 0; p < NPH; ++p) { a.ph_lo = p; a.ph_hi = p + 1; hipLaunchKernelGGL(mk_fwd, dim3(grid), dim3(NTHREADS), LDS_BYTES, stream, a); }
#endif
    const hipError_t le = hipPeekAtLastError();
    if (le != hipSuccess) fprintf(stderr, "kernel_launch: launch failed: %s\n", hipGetErrorName(le));
}
```
